# Optimizing an MI355X kernel written in HIP

```python
import math
import jax, jax.numpy as jnp
from jax import lax
import numpy as np

D_MODEL = 2048
BATCH = 4
SEQ = 4096
DEPTH = 4

GDN_HEADS = 8
GDN_HD = 128
GDN_W = GDN_HEADS * GDN_HD
GDN_CONV = 4
GDN_CHUNK = 64
SC_WIDTH = D_MODEL // 2
SC_CONV = 3
NSA_HEADS = 16
NSA_KV = 4
NSA_HD = 128
NSA_Q = NSA_HEADS * NSA_HD
NSA_KVW = NSA_KV * NSA_HD
CMP_LEN = 32
CMP_STRIDE = 16
CMP_HID = 256
SEL_BLOCK = 64
SEL_N = 16
WIN = 512
ATT_QBLK = 128
SEL_QBLK = 32
FORCE_BONUS = 1000.0
ROPE_THETA = 10000.0
D_FF = 5632
FFN_CONV = 3
EPS = 1e-6
NEG = -1e30

AB_COLS = 4 * GDN_W + 2 * GDN_HEADS + 3 * SC_WIDTH
NSA_COLS = NSA_Q + 6 * NSA_KVW + 3 * NSA_HEADS

kernel_name = "hybrid_deltanet_shortconv_nsa_convffn"


def split_cols(t, widths):
    offs = np.cumsum(widths)[:-1].tolist()
    return jnp.split(t, offs, axis=-1)


def rmsnorm(x, w):
    xf = x.astype(jnp.float32)
    y = xf * lax.rsqrt(jnp.mean(xf * xf, axis=-1, keepdims=True) + EPS)
    return (y * w.astype(jnp.float32)).astype(x.dtype)


def l2norm(x):
    return x * lax.rsqrt(jnp.sum(x * x, axis=-1, keepdims=True) + EPS)


def causal_dwconv(x, w):
    K = w.shape[0]
    S = x.shape[1]
    xp = jnp.pad(x, ((0, 0), (K - 1, 0), (0, 0)))
    return sum(xp[:, k:k + S] * w[k] for k in range(K))


def rope_tables(S, dim):
    inv = 1.0 / (ROPE_THETA ** (jnp.arange(0, dim, 2, dtype=jnp.float32) / dim))
    ang = jnp.arange(S, dtype=jnp.float32)[:, None] * inv[None, :]
    return jnp.cos(ang), jnp.sin(ang)


def apply_rope(x, cos, sin):
    x1, x2 = jnp.split(x, 2, axis=-1)
    c = cos[None, :, None, :]
    s = sin[None, :, None, :]
    return jnp.concatenate([x1 * c - x2 * s, x2 * c + x1 * s], axis=-1)


def gated_delta_chunked(q, k, v, g, beta):
    B, H, S, D = q.shape
    C = GDN_CHUNK
    N = S // C
    q = q * (D ** -0.5)
    rs = lambda t: t.reshape((B, H, N, C) + t.shape[3:])
    q, k, v, beta = rs(q), rs(k), rs(v), rs(beta)
    g = jnp.cumsum(rs(g), axis=-1)
    kb = k * beta[..., None]
    vb = v * beta[..., None]
    tril = jnp.tril(jnp.ones((C, C), dtype=bool))
    stril = jnp.tril(jnp.ones((C, C), dtype=bool), -1)
    gdiff = g[..., :, None] - g[..., None, :]
    decay = jnp.where(tril, jnp.exp(jnp.where(tril, gdiff, 0.0)), 0.0)
    Lm = jnp.where(stril, jnp.einsum('bhnid,bhnjd->bhnij', kb, k) * decay, 0.0)
    eye = jnp.eye(C, dtype=jnp.float32)
    T = lax.linalg.triangular_solve(eye + Lm, jnp.broadcast_to(eye, Lm.shape),
                                    left_side=True, lower=True)
    u = T @ vb
    w = T @ (kb * jnp.exp(g)[..., None])
    qk = jnp.where(tril, jnp.einsum('bhnid,bhnjd->bhnij', q, k) * decay, 0.0)

    def step(state, xs):
        qc, kc, uc, wc, gc, ac = xs
        vnew = uc - wc @ state
        o = (qc * jnp.exp(gc)[..., None]) @ state + ac @ vnew
        glast = gc[..., -1]
        kdec = kc * jnp.exp(glast[..., None] - gc)[..., None]
        state = state * jnp.exp(glast)[..., None, None] + jnp.einsum('bhcd,bhce->bhde', kdec, vnew)
        return state, o

    xs = tuple(jnp.moveaxis(t, 2, 0) for t in (q, k, u, w, g, qk))
    s0 = jnp.zeros((B, H, D, D), jnp.float32)
    _, o = lax.scan(step, s0, xs)
    return jnp.moveaxis(o, 0, 2).reshape(B, H, S, D)


def delta_shortconv_mixer(xn, w_in, w_out, conv_qkv, a_log, dt_bias, o_norm, conv_sc):
    B, S, _ = xn.shape
    H, D = GDN_HEADS, GDN_HD
    f32 = jnp.float32
    q, k, v, z, a, b, hb, gb, gc = split_cols(xn @ w_in, [H * D] * 4 + [H] * 2 + [SC_WIDTH] * 3)
    qkv = jax.nn.silu(causal_dwconv(jnp.concatenate([q, k, v], axis=-1), conv_qkv)).astype(f32)
    q, k, v = [t.reshape(B, S, H, D).transpose(0, 2, 1, 3) for t in jnp.split(qkv, 3, axis=-1)]
    g = -jnp.exp(a_log.astype(f32)) * jax.nn.softplus(a.astype(f32) + dt_bias.astype(f32))
    beta = jax.nn.sigmoid(b.astype(f32))
    o = gated_delta_chunked(l2norm(q), l2norm(k), v, g.transpose(0, 2, 1), beta.transpose(0, 2, 1))
    o = rmsnorm(o.transpose(0, 2, 1, 3), o_norm) * jax.nn.silu(z.astype(f32).reshape(B, S, H, D))
    y_a = o.reshape(B, S, H * D).astype(xn.dtype)
    y_b = gb * causal_dwconv(gc * hb, conv_sc)
    return jnp.concatenate([y_a, y_b], axis=-1) @ w_out


def nsa_compress(t, pos, w1, w2):
    B, G, S, D = t.shape
    r = CMP_LEN // CMP_STRIDE
    nc = S // CMP_STRIDE - r + 1
    tr = t.reshape(B, G, S // CMP_STRIDE, CMP_STRIDE, D)
    blocks = jnp.concatenate([tr[:, :, j:j + nc] for j in range(r)], axis=3)
    blocks = (blocks + pos).reshape(B, G, nc, CMP_LEN * D)
    return jax.nn.gelu(blocks @ w1) @ w2


def nsa_compressed_branch(q, kc, vc):
    S = q.shape[3]
    nc = kc.shape[2]
    t = jnp.arange(S)
    valid = (jnp.arange(nc) * CMP_STRIDE + CMP_LEN - 1)[None, :] <= t[:, None]
    s = jnp.einsum('bgrsd,bgcd->bgrsc', q, kc)
    p = jnp.where(valid, jax.nn.softmax(jnp.where(valid, s, NEG), axis=-1), 0.0)
    return jnp.einsum('bgrsc,bgcd->bgrsd', p, vc), p


def nsa_selected_branch(q, k, v, p_cmp):
    B, G, R, S, D = q.shape
    nc = p_cmp.shape[-1]
    ns = S // SEL_BLOCK
    n_sel = min(SEL_N, ns)
    cs = jnp.arange(nc) * CMP_STRIDE
    ss = jnp.arange(ns) * SEL_BLOCK
    ov = jnp.minimum(cs[:, None] + CMP_LEN, ss[None, :] + SEL_BLOCK) - jnp.maximum(cs[:, None], ss[None, :])
    M = (jnp.clip(ov, 0, None) / CMP_STRIDE).astype(jnp.float32)
    score = jnp.einsum('bgrsc,cn->bgsn', p_cmp, M)
    t = jnp.arange(S)
    blk = jnp.arange(ns)
    cur = (t // SEL_BLOCK)[:, None]
    valid = blk[None, :] * SEL_BLOCK <= t[:, None]
    forced = (blk[None, :] == 0) | (blk[None, :] == cur) | (blk[None, :] == cur - 1)
    score = jnp.where(valid, score + jnp.where(forced, FORCE_BONUS, 0.0), NEG)
    _, idx = lax.top_k(score, n_sel)

    kb = k.reshape(B, G, ns, SEL_BLOCK, D)
    vb = v.reshape(B, G, ns, SEL_BLOCK, D)
    nq = S // SEL_QBLK
    q_ch = q.reshape(B, G, R, nq, SEL_QBLK, D).transpose(3, 0, 1, 2, 4, 5)
    i_ch = idx.reshape(B, G, nq, SEL_QBLK, n_sel).transpose(2, 0, 1, 3, 4)
    t_ch = t.reshape(nq, SEL_QBLK)
    bi = jnp.arange(B)[:, None, None, None]
    gi = jnp.arange(G)[None, :, None, None]

    def block(args):
        qb, ib, tb = args
        kg = kb[bi, gi, ib].reshape(B, G, SEL_QBLK, n_sel * SEL_BLOCK, D)
        vg = vb[bi, gi, ib].reshape(B, G, SEL_QBLK, n_sel * SEL_BLOCK, D)
        kpos = (ib[..., None] * SEL_BLOCK + jnp.arange(SEL_BLOCK)).reshape(B, G, SEL_QBLK, n_sel * SEL_BLOCK)
        mask = (kpos <= tb[None, None, :, None])[:, :, None]
        s = jnp.einsum('bgrqd,bgqkd->bgrqk', qb, kg)
        p = jax.nn.softmax(jnp.where(mask, s, NEG), axis=-1)
        return jnp.einsum('bgrqk,bgqkd->bgrqd', p, vg)

    o = lax.map(block, (q_ch, i_ch, t_ch))
    return o.transpose(1, 2, 3, 0, 4, 5).reshape(B, G, R, S, D)


def nsa_window_branch(q, k, v):
    B, G, R, S, D = q.shape
    QB = ATT_QBLK
    KL = WIN + QB
    nb = S // QB
    kp = jnp.pad(k, ((0, 0), (0, 0), (WIN, 0), (0, 0)))
    vp = jnp.pad(v, ((0, 0), (0, 0), (WIN, 0), (0, 0)))
    q_bl = q.reshape(B, G, R, nb, QB, D).transpose(3, 0, 1, 2, 4, 5)

    def block(args):
        qb, i = args
        start = i * QB
        kb = lax.dynamic_slice_in_dim(kp, start, KL, axis=2)
        vb = lax.dynamic_slice_in_dim(vp, start, KL, axis=2)
        tq = start + jnp.arange(QB)
        tk = start - WIN + jnp.arange(KL)
        mask = (tk[None, :] <= tq[:, None]) & (tk[None, :] > tq[:, None] - WIN) & (tk[None, :] >= 0)
        s = jnp.einsum('bgrqd,bgkd->bgrqk', qb, kb)
        p = jax.nn.softmax(jnp.where(mask, s, NEG), axis=-1)
        return jnp.einsum('bgrqk,bgkd->bgrqd', p, vb)

    o = lax.map(block, (q_bl, jnp.arange(nb)))
    return o.transpose(1, 2, 3, 0, 4, 5).reshape(B, G, R, S, D)


def nsa_mixer(xn, w_in, w_out, pos_k, w1_k, w2_k, pos_v, w1_v, w2_v, cos, sin):
    B, S, _ = xn.shape
    H, G, D = NSA_HEADS, NSA_KV, NSA_HD
    R = H // G
    f32 = jnp.float32
    q, kc, vc, ks, vs, kw, vw, gt = split_cols((xn @ w_in).astype(f32), [H * D] + [G * D] * 6 + [3 * H])
    q = apply_rope(q.reshape(B, S, H, D), cos, sin) * (D ** -0.5)
    q = q.reshape(B, S, G, R, D).transpose(0, 2, 3, 1, 4)
    rk = lambda t: apply_rope(t.reshape(B, S, G, D), cos, sin).transpose(0, 2, 1, 3)
    rv = lambda t: t.reshape(B, S, G, D).transpose(0, 2, 1, 3)
    kc, ks, kw = rk(kc), rk(ks), rk(kw)
    vc, vs, vw = rv(vc), rv(vs), rv(vw)
    gates = jax.nn.sigmoid(gt).reshape(B, S, 3, G, R).transpose(2, 0, 3, 4, 1)[..., None]
    kcmp = nsa_compress(kc, pos_k.astype(f32), w1_k.astype(f32), w2_k.astype(f32))
    vcmp = nsa_compress(vc, pos_v.astype(f32), w1_v.astype(f32), w2_v.astype(f32))
    o_cmp, p_cmp = nsa_compressed_branch(q, kcmp, vcmp)
    o_slc = nsa_selected_branch(q, ks, vs, p_cmp)
    o_win = nsa_window_branch(q, kw, vw)
    o = gates[0] * o_cmp + gates[1] * o_slc + gates[2] * o_win
    o = o.transpose(0, 3, 1, 2, 4).reshape(B, S, H * D).astype(xn.dtype)
    return o @ w_out


def conv_ffn(xn, w_gu, conv_w, w_down):
    gate, up = jnp.split(xn @ w_gu, 2, axis=-1)
    return (jax.nn.silu(causal_dwconv(gate, conv_w)) * up) @ w_down


def setup_inputs(seed: int = 0) -> dict:
    key = jax.random.key(seed)
    ks = iter(jax.random.split(key, 32))
    nrm = lambda shape, scale: jax.random.normal(next(ks), shape, jnp.float32) * scale
    NE = (DEPTH + 1) // 2
    NO = DEPTH // 2
    x = nrm((BATCH, SEQ, D_MODEL), 1.0)
    norm_w = 1.0 + nrm((DEPTH, 4, D_MODEL), 0.02)
    ab_w_in = nrm((NE, D_MODEL, AB_COLS), D_MODEL ** -0.5)
    ab_w_out = nrm((NE, GDN_W + SC_WIDTH, D_MODEL), (GDN_W + SC_WIDTH) ** -0.5)
    gdn_conv = nrm((NE, GDN_CONV, 3 * GDN_W), GDN_CONV ** -0.5)
    gdn_a_log = jnp.log(jax.random.uniform(next(ks), (NE, GDN_HEADS), jnp.float32, 1.0, 16.0))
    dt = jnp.exp(jax.random.uniform(next(ks), (NE, GDN_HEADS), jnp.float32, math.log(1e-3), math.log(1e-1)))
    gdn_dt_bias = dt + jnp.log(-jnp.expm1(-dt))
    gdn_norm = 1.0 + nrm((NE, GDN_HD), 0.02)
    sc_conv = nrm((NE, SC_CONV, SC_WIDTH), SC_CONV ** -0.5)
    nsa_w_in = nrm((NO, D_MODEL, NSA_COLS), D_MODEL ** -0.5)
    nsa_w_out = nrm((NO, NSA_Q, D_MODEL), NSA_Q ** -0.5)
    cmp_pos_k = nrm((NO, CMP_LEN, NSA_HD), 0.02)
    cmp_w1_k = nrm((NO, CMP_LEN * NSA_HD, CMP_HID), (CMP_LEN * NSA_HD) ** -0.5)
    cmp_w2_k = nrm((NO, CMP_HID, NSA_HD), CMP_HID ** -0.5)
    cmp_pos_v = nrm((NO, CMP_LEN, NSA_HD), 0.02)
    cmp_w1_v = nrm((NO, CMP_LEN * NSA_HD, CMP_HID), (CMP_LEN * NSA_HD) ** -0.5)
    cmp_w2_v = nrm((NO, CMP_HID, NSA_HD), CMP_HID ** -0.5)
    ffn_w_gu = nrm((DEPTH, D_MODEL, 2 * D_FF), D_MODEL ** -0.5)
    ffn_conv = nrm((DEPTH, FFN_CONV, D_FF), FFN_CONV ** -0.5)
    ffn_w_down = nrm((DEPTH, D_FF, D_MODEL), D_FF ** -0.5)
    return {"x": x, "norm_w": norm_w, "ab_w_in": ab_w_in, "ab_w_out": ab_w_out,
            "gdn_conv": gdn_conv, "gdn_a_log": gdn_a_log, "gdn_dt_bias": gdn_dt_bias,
            "gdn_norm": gdn_norm, "sc_conv": sc_conv, "nsa_w_in": nsa_w_in, "nsa_w_out": nsa_w_out,
            "cmp_pos_k": cmp_pos_k, "cmp_w1_k": cmp_w1_k, "cmp_w2_k": cmp_w2_k,
            "cmp_pos_v": cmp_pos_v, "cmp_w1_v": cmp_w1_v, "cmp_w2_v": cmp_w2_v,
            "ffn_w_gu": ffn_w_gu, "ffn_conv": ffn_conv, "ffn_w_down": ffn_w_down}


def reference(x, norm_w, ab_w_in, ab_w_out, gdn_conv, gdn_a_log, gdn_dt_bias, gdn_norm, sc_conv,
              nsa_w_in, nsa_w_out, cmp_pos_k, cmp_w1_k, cmp_w2_k, cmp_pos_v, cmp_w1_v, cmp_w2_v,
              ffn_w_gu, ffn_conv, ffn_w_down):
    cos, sin = rope_tables(x.shape[1], NSA_HD)
    h = x
    for l in range(DEPTH):
        i = l // 2
        xn = rmsnorm(h, norm_w[l, 0])
        if l % 2 == 0:
            m = delta_shortconv_mixer(xn, ab_w_in[i], ab_w_out[i], gdn_conv[i], gdn_a_log[i],
                                      gdn_dt_bias[i], gdn_norm[i], sc_conv[i])
        else:
            m = nsa_mixer(xn, nsa_w_in[i], nsa_w_out[i], cmp_pos_k[i], cmp_w1_k[i], cmp_w2_k[i],
                          cmp_pos_v[i], cmp_w1_v[i], cmp_w2_v[i], cos, sin)
        h = h + rmsnorm(m, norm_w[l, 1])
        f = conv_ffn(rmsnorm(h, norm_w[l, 2]), ffn_w_gu[l], ffn_conv[l], ffn_w_down[l])
        h = h + rmsnorm(f, norm_w[l, 3])
    return h
```

```cpp
#include <hip/hip_runtime.h>
#include <cstdio>
#include <cstdint>

#define GAS __attribute__((address_space(1)))
#define LAS __attribute__((address_space(3)))
#define DI __device__ __forceinline__
typedef unsigned short bf16;
typedef short bf16x8 __attribute__((ext_vector_type(8)));
typedef float f32x4 __attribute__((ext_vector_type(4)));
typedef float f32x2 __attribute__((ext_vector_type(2)));
typedef unsigned u32x4 __attribute__((ext_vector_type(4)));
typedef unsigned u32x2 __attribute__((ext_vector_type(2)));
typedef __bf16 bfv2 __attribute__((ext_vector_type(2)));

DI unsigned pk2(float a, float b) { f32x2 v = {a, b}; bfv2 r = __builtin_convertvector(v, bfv2); return __builtin_bit_cast(unsigned, r); }
DI bf16 f2bf(float a) { return (bf16)(pk2(a, 0.f) & 0xffffu); }
DI float bf2f(bf16 b) { return __uint_as_float(((unsigned)b) << 16); }
DI float bflo(unsigned w) { return __uint_as_float(w << 16); }
DI float bfhi(unsigned w) { return __uint_as_float(w & 0xffff0000u); }
DI float silu_f(float x) { return x * __builtin_amdgcn_rcpf(1.f + __expf(-x)); }
DI float sigmoid_f(float x) { return __builtin_amdgcn_rcpf(1.f + __expf(-x)); }
DI bf16x8 pack8(f32x4 a, f32x4 b) { u32x4 p; p.x = pk2(a.x, a.y); p.y = pk2(a.z, a.w); p.z = pk2(b.x, b.y); p.w = pk2(b.z, b.w); return __builtin_bit_cast(bf16x8, p); }
#define MFMA16(a, b, c) __builtin_amdgcn_mfma_f32_16x16x32_bf16((a), (b), (c), 0, 0, 0)
DI float wave_sum(float v) {
#pragma unroll
    for (int o = 1; o < 64; o <<= 1) v += __shfl_xor(v, o);
    return v;
}

DI float max2f(float a, float b) { float r; asm("v_max_f32 %0, %1, %2" : "=v"(r) : "v"(a), "v"(b)); return r; }
DI float max3f(float a, float b, float c) { float r; asm("v_max3_f32 %0, %1, %2, %3" : "=v"(r) : "v"(a), "v"(b), "v"(c)); return r; }
DI float max16f(const f32x4 (&s)[4]) {
    const float a = max3f(s[0][0], s[0][1], s[0][2]), b = max3f(s[0][3], s[1][0], s[1][1]), c = max3f(s[1][2], s[1][3], s[2][0]), d = max3f(s[2][1], s[2][2], s[2][3]), e = max3f(s[3][0], s[3][1], s[3][2]);
    return max3f(max3f(a, b, c), max3f(d, e, s[3][3]), s[3][3]);
}
typedef float f32x2 __attribute__((ext_vector_type(2)));
DI f32x2 sub_pk(f32x2 a, f32x2 b) { f32x2 r; asm("v_pk_add_f32 %0, %1, %2 neg_lo:[0,1] neg_hi:[0,1]" : "=v"(r) : "v"(a), "v"(b)); return r; }
DI void scale_inplace(f32x4& o, float al) {
    f32x2 lo = {o.x, o.y}, hi = {o.z, o.w}; const f32x2 a2 = {al, al};
    asm("v_pk_mul_f32 %0, %0, %1" : "+v"(lo) : "v"(a2)); asm("v_pk_mul_f32 %0, %0, %1" : "+v"(hi) : "v"(a2));
    o = (f32x4){lo.x, lo.y, hi.x, hi.y};
}
DI float quad_max(float v) {
    auto q = __builtin_amdgcn_permlane16_swap(__float_as_uint(v), __float_as_uint(v), false, false); v = max2f(__uint_as_float(q[0]), __uint_as_float(q[1]));
    auto r = __builtin_amdgcn_permlane32_swap(__float_as_uint(v), __float_as_uint(v), false, false); return max2f(__uint_as_float(r[0]), __uint_as_float(r[1])); }
DI float quad_sum(float v) {
    auto q = __builtin_amdgcn_permlane16_swap(__float_as_uint(v), __float_as_uint(v), false, false); v = __uint_as_float(q[0]) + __uint_as_float(q[1]);
    auto r = __builtin_amdgcn_permlane32_swap(__float_as_uint(v), __float_as_uint(v), false, false); return __uint_as_float(r[0]) + __uint_as_float(r[1]); }

namespace pg8 {
#define PG8_LAS __attribute__((address_space(3)))
typedef unsigned short bf16_t;
constexpr int BM = 256, BK = 64, HALF = 128, HTB = HALF * BK * 2, STAGE_BYTES = 8 * HTB, NXCD = 8, WGM = 8;
__host__ __device__ __forceinline__ int lds_byte(int r, int c) { const int st = (r >> 4) * 2 + (c >> 5), rr = r & 15, cc = c & 31, ob = rr * 64 + cc * 2; return st * 1024 + (ob ^ (((ob >> 9) & 1) << 5)); }
__host__ __device__ __forceinline__ void stage_rc(int b, int& R, int& C) { const int st = b / 1024, sb = b % 1024, swz = sb ^ (((sb >> 9) & 1) << 5); R = (st >> 1) * 16 + swz / 64; C = (st & 1) * 32 + (swz % 64) / 2; }
__host__ __device__ __forceinline__ int perm32(int rho) { const int n = rho >> 4, i = rho & 15; return 8 * (i >> 2) + 4 * n + (i & 3); }
struct Unit { int pm, pn; };
struct Gemm { const bf16_t* A; const bf16_t* Bt; int M, N, K, lda, ldb; };
struct StaticOrder {
    int nM, nN, nwg, G, c;
    __host__ __device__ void init(int M, int N, int G_, int c_) { nM = M / BM; nN = N / BM; nwg = nM * nN; G = G_; c = c_; }
    __host__ __device__ bool next(int i, Unit& u) const {
        const long L = (long)i * G + c; if (L >= nwg || c < 0) return false;
        int wgid = (int)L; { const int q = nwg / NXCD, r = nwg % NXCD, xcd = wgid % NXCD, off = wgid / NXCD; wgid = (xcd < r ? xcd * (q + 1) : r * (q + 1) + (xcd - r) * q) + off; }
        const int nig = WGM * nN, gid = wgid / nig, fm = gid * WGM, gsz = (nM - fm) < WGM ? (nM - fm) : WGM;
        u.pm = fm + ((wgid % nig) % gsz); u.pn = (wgid % nig) / gsz; return true;
    }
    __device__ __forceinline__ void a_ready(const Unit&) const {}
    __device__ __forceinline__ void done(const Unit&) const {}
};
__device__ __forceinline__ float gelu_tanh(float x) { const float y = 0.7978845608028654f * (x + 0.044715f * x * x * x); const float e = __expf(2.f * y); const float th = 1.f - 2.f / (e + 1.f); return 0.5f * x * (1.f + th); }
template <int ACT> struct EpiBf16 {
    static constexpr bool PERM = true, AFTER_DRAIN = false;
    bf16_t* O; int ldc; const float* bias;
    __device__ __forceinline__ void operator()(const f32x4 (&acc)[2][2][4][2], const Unit& u, int wr, int wc, int fr, int fq) const {
        const int row0 = u.pm * BM + wr * 64 + fr; const int col0 = u.pn * BM + wc * 32 + 8 * fq;
        f32x4 bv[2][2];
#pragma unroll
        for (int bj = 0; bj < 2; ++bj)
#pragma unroll
            for (int n = 0; n < 2; ++n) bv[bj][n] = bias ? *(const f32x4*)(bias + col0 + bj * HALF + 4 * n) : (f32x4){0.f, 0.f, 0.f, 0.f};
#pragma unroll
        for (int ai = 0; ai < 2; ++ai)
#pragma unroll
            for (int m = 0; m < 4; ++m) { bf16_t* rowp = O + (size_t)(row0 + ai * HALF + m * 16) * ldc + col0;
#pragma unroll
                for (int bj = 0; bj < 2; ++bj) { f32x4 v0 = acc[ai][bj][m][0] + bv[bj][0], v1 = acc[ai][bj][m][1] + bv[bj][1];
                    if (ACT == 1) {
#pragma unroll
                        for (int j = 0; j < 4; ++j) { v0[j] = gelu_tanh(v0[j]); v1[j] = gelu_tanh(v1[j]); } }
                    u32x4 w; w.x = pk2(v0[0], v0[1]); w.y = pk2(v0[2], v0[3]); w.z = pk2(v1[0], v1[1]); w.w = pk2(v1[2], v1[3]);
                    *(u32x4*)(rowp + bj * HALF) = w; } }
    }
};
struct EpiF32 {
    static constexpr bool PERM = false, AFTER_DRAIN = false;
    float* C; int ldc;
    __device__ __forceinline__ void operator()(const f32x4 (&acc)[2][2][4][2], const Unit& u, int wr, int wc, int fr, int fq) const {
        const int row0 = u.pm * BM + wr * 64 + fr, col0 = u.pn * BM + wc * 32 + 4 * fq;
#pragma unroll
        for (int ai = 0; ai < 2; ++ai)
#pragma unroll
            for (int m = 0; m < 4; ++m) { float* rowp = C + (size_t)(row0 + ai * HALF + m * 16) * ldc + col0;
#pragma unroll
                for (int bj = 0; bj < 2; ++bj)
#pragma unroll
                    for (int n = 0; n < 2; ++n) *(f32x4*)(rowp + bj * HALF + n * 16) = acc[ai][bj][m][n]; }
    }
};
template <bool ISV> struct EpiFrag {
    static constexpr bool PERM = false, AFTER_DRAIN = false;
    bf16_t* O;
    __device__ __forceinline__ void operator()(const f32x4 (&acc)[2][2][4][2], const Unit& u, int wr, int wc, int fr, int fq) const {
        bf16_t* base = O + (size_t)u.pm * 32768;
#pragma unroll
        for (int ai = 0; ai < 2; ++ai)
#pragma unroll
            for (int m = 0; m < 4; ++m) { const int c = ai * HALF + wr * 64 + m * 16 + fr;
#pragma unroll
                for (int n = 0; n < 2; ++n) { const int d = wc * 32 + 16 * n + 4 * fq; const f32x4 v = acc[ai][0][m][n];
                    if (!ISV) { const int off = (c >> 6) * 8192 + ((((c >> 4) & 3) * 4 + (d >> 5)) * 64 + ((d >> 3) & 3) * 16 + (c & 15)) * 8 + (d & 7);
                        u32x2 w; w.x = pk2(v[0], v[1]); w.y = pk2(v[2], v[3]); *(u32x2*)(base + off) = w; }
                    else { const int ck = c & 63, off = (c >> 6) * 8192 + (((d >> 4) * 2 + (ck >> 5)) * 64 + ((ck >> 2) & 3) * 16 + (d & 15)) * 8 + ((ck >> 4) & 1) * 4 + (ck & 3);
#pragma unroll
                        for (int j = 0; j < 4; ++j) base[off + 8 * j] = f2bf(v[j]); } } }
    }
};

__device__ __forceinline__ float dpp_ror1(float v) { return __int_as_float(__builtin_amdgcn_update_dpp(0, __float_as_int(v), 0x121, 0xF, 0xF, false)); }
__device__ __forceinline__ float dpp_ror2(float v) { return __int_as_float(__builtin_amdgcn_update_dpp(0, __float_as_int(v), 0x122, 0xF, 0xF, false)); }
__device__ __forceinline__ float silu_fast(float x) { return x * __builtin_amdgcn_rcpf(1.f + __expf(-x)); }
struct EpiAct {
    static constexpr bool PERM = true, AFTER_DRAIN = false;
    bf16_t* ACT; const float* cw; float* SG; float* S0; PG8_LAS float* X; int dff;
    __device__ __forceinline__ void operator()(const f32x4 (&acc)[2][2][4][2], const Unit& u, int wr, int wc, int fr, int fq) const {
        const int ch0 = u.pn * 128 + wc * 32 + 8 * fq;
        if (fr >= 14) {
#pragma unroll
            for (int ai = 0; ai < 2; ++ai) { PG8_LAS float* xp = X + ((wc * 4 + 2 * ai + wr) * 64 + fq * 8) * 2 + (fr - 14);
#pragma unroll
                for (int n = 0; n < 2; ++n)
#pragma unroll
                    for (int j = 0; j < 4; ++j) xp[(n * 4 + j) * 2] = acc[ai][0][3][n][j]; }
        }
        asm volatile("s_waitcnt lgkmcnt(0)" ::: "memory"); __builtin_amdgcn_s_barrier(); asm volatile("" ::: "memory");
#pragma unroll
        for (int n = 0; n < 2; ++n) {
            f32x4 w[3];
#pragma unroll
            for (int k = 0; k < 3; ++k) w[k] = *(const f32x4*)(cw + (size_t)k * dff + ch0 + 4 * n);
#pragma unroll
            for (int ai = 0; ai < 2; ++ai) {
                const int strip = 2 * ai + wr;
                f32x4 h1 = {0.f, 0.f, 0.f, 0.f}, h2 = {0.f, 0.f, 0.f, 0.f};
                if (strip > 0) { const PG8_LAS f32x2* xp = (const PG8_LAS f32x2*)(X + ((wc * 4 + strip - 1) * 64 + fq * 8 + n * 4) * 2);
#pragma unroll
                    for (int j = 0; j < 4; ++j) { const f32x2 q = xp[j]; h2[j] = q.x; h1[j] = q.y; } }
                f32x4 pr1 = h1, pr2 = (fr == 0) ? h2 : h1;
#pragma unroll
                for (int m = 0; m < 4; ++m) {
                    const f32x4 g = acc[ai][0][m][n], up = acc[ai][1][m][n];
                    f32x4 r1, r2, a;
#pragma unroll
                    for (int j = 0; j < 4; ++j) { r1[j] = dpp_ror1(g[j]); r2[j] = dpp_ror2(g[j]); }
#pragma unroll
                    for (int j = 0; j < 4; ++j) { const float p1 = fr >= 1 ? r1[j] : pr1[j], p2 = fr >= 2 ? r2[j] : pr2[j];
                        a[j] = silu_fast(w[0][j] * p2 + w[1][j] * p1 + w[2][j] * g[j]) * up[j]; }
                    pr1 = r1; pr2 = r2;
                    u32x2 o; o.x = pk2(a[0], a[1]); o.y = pk2(a[2], a[3]);
                    *(u32x2*)(ACT + (size_t)(u.pm * BM + ai * HALF + wr * 64 + m * 16 + fr) * dff + ch0 + 4 * n) = o;
                }
            }
        }
        if (wr == 1 && fr >= 14) { float* p = SG + ((size_t)u.pm * 2 + (fr - 14)) * dff + ch0; *(f32x4*)p = acc[1][0][3][0]; *(f32x4*)(p + 4) = acc[1][0][3][1]; }
        if (wr == 0 && fr < 2) { float* p = S0 + (((size_t)u.pm * 2 + fr) * 2) * dff + ch0; *(f32x4*)p = acc[0][0][0][0]; *(f32x4*)(p + 4) = acc[0][0][0][1]; *(f32x4*)(p + dff) = acc[0][1][0][0]; *(f32x4*)(p + dff + 4) = acc[0][1][0][1]; }
    }
};
template <class Epi, class Sched, bool ALIGN_EPI = false, bool SP2 = false>
__device__ __forceinline__ void gemm_phase(PG8_LAS unsigned char* lds, const Gemm g, const Sched& S, const Epi& E, const int tid) {
    const int wid = __builtin_amdgcn_readfirstlane(tid >> 6), lane = tid & 63, wr = wid >> 2, wc = wid & 3, fr = lane & 15, fq = lane >> 4;
    const int K = g.K, nt = K / BK;
    unsigned voffA[2], voffB[2];
#pragma unroll
    for (int i = 0; i < 2; ++i) { int R, C; stage_rc(tid * 16 + i * 8192, R, C); const int Rb = Epi::PERM ? ((R & ~31) + perm32(R & 31)) : R;
        voffA[i] = (unsigned)(R * g.lda + C) * 2u; voffB[i] = (unsigned)(Rb * g.ldb + C) * 2u; }
    const size_t kstep = (size_t)(BK * 2);
    const size_t hstepA = (size_t)HALF * g.lda * 2, hstepB = (size_t)HALF * g.ldb * 2;
    const size_t tstepA = 2 * hstepA, tstepB = 2 * hstepB;
    const unsigned ldsw = (unsigned)wid * 1024u;
    const int aoff = lds_byte(wr * 64 + fr, fq * 8), boff = lds_byte(wc * 32 + fr, fq * 8);
#define PG8_SA(b, h) (((b) * 2 + (h)) * HTB)
#define PG8_SB(b, h) ((4 + (b) * 2 + (h)) * HTB)
#define PG8_STAGE(bufoff, gbase, voff) do { _Pragma("unroll") for (int _i = 0; _i < 2; ++_i) \
        __builtin_amdgcn_global_load_lds((const unsigned*)((const char*)(gbase) + (voff)[_i]), (PG8_LAS unsigned*)(lds + (bufoff) + ldsw + _i * 8192), 16, 0, 0); } while (0)
#define PG8_LDA(dst, b, h) do { _Pragma("unroll") for (int m = 0; m < 4; ++m) _Pragma("unroll") for (int k = 0; k < 2; ++k) dst[m][k] = *(const PG8_LAS bf16x8*)(lds + PG8_SA(b, h) + aoff + m * 2048 + k * 1024); } while (0)
#define PG8_LDB(dst, b, h) do { _Pragma("unroll") for (int n = 0; n < 2; ++n) _Pragma("unroll") for (int k = 0; k < 2; ++k) dst[n][k] = *(const PG8_LAS bf16x8*)(lds + PG8_SB(b, h) + boff + n * 2048 + k * 1024); } while (0)
#define PG8_MMA(ai, bj, At, Bt) do { __builtin_amdgcn_s_setprio(1); _Pragma("unroll") for (int m = 0; m < 4; ++m) _Pragma("unroll") for (int n = 0; n < 2; ++n) _Pragma("unroll") for (int k = 0; k < 2; ++k) \
        acc[ai][bj][m][n] = __builtin_amdgcn_mfma_f32_16x16x32_bf16(Bt[n][k], At[m][k], acc[ai][bj][m][n], 0, 0, 0); __builtin_amdgcn_s_setprio(0); } while (0)
#define PG8_WAIT_V(n) asm volatile("s_waitcnt vmcnt(" #n ")" ::: "memory")
#define PG8_WAIT_L(n) asm volatile("s_waitcnt lgkmcnt(" #n ")" ::: "memory")
#define PG8_BAR __builtin_amdgcn_s_barrier()
#define PG8_SCHED __builtin_amdgcn_sched_barrier(0)
    Unit cur, nxt; int ui = 0;
    if (!S.next(0, cur)) return;
    f32x4 acc[2][2][4][2];
#pragma unroll
    for (int a = 0; a < 2; ++a)
#pragma unroll
        for (int b = 0; b < 2; ++b)
#pragma unroll
            for (int m = 0; m < 4; ++m)
#pragma unroll
                for (int n = 0; n < 2; ++n) acc[a][b][m][n] = (f32x4){0.f, 0.f, 0.f, 0.f};
    bf16x8 At[4][2], B0[2][2], B1[2][2];
    const char* cA = (const char*)g.A + (size_t)cur.pm * tstepA; const char* cB = (const char*)g.Bt + (size_t)cur.pn * tstepB;
    S.a_ready(cur);
    if constexpr (SP2) {
        PG8_STAGE(PG8_SB(0, 0), cB, voffB); PG8_STAGE(PG8_SB(0, 1), cB + hstepB, voffB); PG8_STAGE(PG8_SA(0, 0), cA, voffA); PG8_STAGE(PG8_SA(0, 1), cA + hstepA, voffA);
        if (wr == 1) PG8_BAR;
        PG8_WAIT_V(2); PG8_BAR;
        PG8_STAGE(PG8_SB(1, 0), cB + kstep, voffB); PG8_STAGE(PG8_SA(1, 0), cA + kstep, voffA); PG8_STAGE(PG8_SB(1, 1), cB + hstepB + kstep, voffB);
        PG8_WAIT_V(6); PG8_BAR;
    } else {
        PG8_STAGE(PG8_SB(0, 0), cB, voffB); PG8_STAGE(PG8_SA(0, 0), cA, voffA); PG8_STAGE(PG8_SB(0, 1), cB + hstepB, voffB); PG8_STAGE(PG8_SA(0, 1), cA + hstepA, voffA);
        if (wr == 1) PG8_BAR;
        PG8_WAIT_V(4); PG8_BAR;
        PG8_STAGE(PG8_SB(1, 0), cB + kstep, voffB); PG8_STAGE(PG8_SA(1, 0), cA + kstep, voffA); PG8_STAGE(PG8_SB(1, 1), cB + hstepB + kstep, voffB);
        PG8_WAIT_V(6); PG8_BAR;
    }
    for (;;) {
        const bool has_next = S.next(ui + 1, nxt);
        const char* nA = has_next ? (const char*)g.A + (size_t)nxt.pm * tstepA : cA; const char* nB = has_next ? (const char*)g.Bt + (size_t)nxt.pn * tstepB : cB;
        for (int t = 0; t < nt; t += 2) {
            const bool last = (t == nt - 2);
            const char* a1 = cA + (size_t)(t + 1) * kstep;
            const char* a2 = last ? nA : cA + (size_t)(t + 2) * kstep; const char* b2 = last ? nB : cB + (size_t)(t + 2) * kstep;
            const char* a3 = a2 + kstep; const char* b3 = b2 + kstep;
            if (last && has_next) S.a_ready(nxt);
            if constexpr (SP2) {
            PG8_LDB(B0, 0, 0); PG8_LDB(B1, 0, 1); PG8_SCHED; PG8_LDA(At, 0, 0); PG8_STAGE(PG8_SA(1, 1), a1 + hstepA, voffA);
            PG8_WAIT_V(8); PG8_WAIT_L(0); PG8_BAR; PG8_MMA(0, 0, At, B0); PG8_MMA(0, 1, At, B1); PG8_BAR; PG8_SCHED;
            PG8_LDA(At, 0, 1); PG8_STAGE(PG8_SB(0, 0), b2, voffB); PG8_STAGE(PG8_SB(0, 1), b2 + hstepB, voffB); PG8_STAGE(PG8_SA(0, 0), a2, voffA);
            PG8_WAIT_V(8); PG8_WAIT_L(0); PG8_BAR; PG8_MMA(1, 0, At, B0); PG8_MMA(1, 1, At, B1); PG8_BAR; PG8_SCHED;
            PG8_LDB(B0, 1, 0); PG8_LDB(B1, 1, 1); PG8_SCHED; PG8_LDA(At, 1, 0); PG8_STAGE(PG8_SA(0, 1), a2 + hstepA, voffA);
            PG8_WAIT_V(8); PG8_WAIT_L(0); PG8_BAR; PG8_MMA(0, 0, At, B0); PG8_MMA(0, 1, At, B1); PG8_BAR; PG8_SCHED;
            PG8_LDA(At, 1, 1); PG8_STAGE(PG8_SB(1, 0), b3, voffB); PG8_STAGE(PG8_SB(1, 1), b3 + hstepB, voffB); PG8_STAGE(PG8_SA(1, 0), a3, voffA);
            PG8_WAIT_V(8); PG8_WAIT_L(0); PG8_BAR; PG8_MMA(1, 0, At, B0); PG8_MMA(1, 1, At, B1); PG8_BAR; PG8_SCHED;
            } else {
            PG8_LDB(B0, 0, 0); PG8_SCHED; PG8_LDA(At, 0, 0); PG8_STAGE(PG8_SA(1, 1), a1 + hstepA, voffA);
            PG8_WAIT_L(8); PG8_BAR; PG8_WAIT_L(0); PG8_MMA(0, 0, At, B0); PG8_BAR; PG8_SCHED;
            PG8_LDB(B1, 0, 1); PG8_STAGE(PG8_SB(0, 0), b2, voffB);
            PG8_BAR; PG8_WAIT_L(0); PG8_MMA(0, 1, At, B1); PG8_BAR;
            PG8_LDA(At, 0, 1); PG8_STAGE(PG8_SA(0, 0), a2, voffA);
            PG8_BAR; PG8_WAIT_L(0); PG8_MMA(1, 0, At, B0); PG8_BAR; PG8_SCHED;
            PG8_STAGE(PG8_SB(0, 1), b2 + hstepB, voffB);
            PG8_WAIT_V(6); PG8_BAR; PG8_MMA(1, 1, At, B1); PG8_BAR;
            PG8_LDB(B0, 1, 0); PG8_SCHED; PG8_LDA(At, 1, 0); PG8_STAGE(PG8_SA(0, 1), a2 + hstepA, voffA);
            PG8_WAIT_L(8); PG8_BAR; PG8_WAIT_L(0); PG8_MMA(0, 0, At, B0); PG8_BAR; PG8_SCHED;
            PG8_LDB(B1, 1, 1); PG8_STAGE(PG8_SB(1, 0), b3, voffB);
            PG8_BAR; PG8_WAIT_L(0); PG8_MMA(0, 1, At, B1); PG8_BAR;
            PG8_LDA(At, 1, 1); PG8_STAGE(PG8_SA(1, 0), a3, voffA);
            PG8_BAR; PG8_WAIT_L(0); PG8_MMA(1, 0, At, B0); PG8_BAR; PG8_SCHED;
            PG8_STAGE(PG8_SB(1, 1), b3 + hstepB, voffB);
            PG8_WAIT_V(6); PG8_BAR; PG8_MMA(1, 1, At, B1); PG8_BAR;
            }
        }
        if constexpr (ALIGN_EPI) { if (wr == 0) PG8_BAR; }
        if constexpr (!Epi::AFTER_DRAIN) { E(acc, cur, wr, wc, fr, fq); S.done(cur); }
        if (!has_next) break;
#pragma unroll
        for (int a = 0; a < 2; ++a)
#pragma unroll
            for (int b = 0; b < 2; ++b)
#pragma unroll
                for (int m = 0; m < 4; ++m)
#pragma unroll
                    for (int n = 0; n < 2; ++n) acc[a][b][m][n] = (f32x4){0.f, 0.f, 0.f, 0.f};
        cur = nxt; cA = nA; cB = nB; ++ui;
        if constexpr (ALIGN_EPI) { if (wr == 1) PG8_BAR; }
    }
    PG8_WAIT_V(0);
    if constexpr (!ALIGN_EPI) { if (wr == 0) PG8_BAR; }
    PG8_BAR;
    if constexpr (Epi::AFTER_DRAIN) { E.fused(acc, cur, wr, wc, fr, fq, lds, wid, lane); S.done(cur); }
#undef PG8_SA
#undef PG8_SB
#undef PG8_STAGE
#undef PG8_LDA
#undef PG8_LDB
#undef PG8_MMA
#undef PG8_WAIT_V
#undef PG8_WAIT_L
#undef PG8_BAR
#undef PG8_SCHED
}
}

#define XB_TMO      128
#define XB_XCNT(j)  (256  + 64 * (j))
#define XB_XSUB(j)  (1280 + 64 * (j))
#define XB_XGEN(j)  (2304 + 64 * (j))
#define XB_TOP      3328
#define XB_TOPGEN   3392
#define XCD_BAR_WORDS 3456
#define XB_SPIN_CAP (1u << 22)
__device__ __forceinline__ unsigned xb_ld(unsigned* p)              { return __hip_atomic_load(p, __ATOMIC_RELAXED, __HIP_MEMORY_SCOPE_AGENT); }
__device__ __forceinline__ unsigned xb_add(unsigned* p, unsigned v) { return __hip_atomic_fetch_add(p, v, __ATOMIC_RELAXED, __HIP_MEMORY_SCOPE_AGENT); }
__device__ __forceinline__ unsigned xb_xcc_id() { return (unsigned)__builtin_amdgcn_s_getreg((3 << 11) | 20) & 0xFu; }
#define XB_SPIN(cond, bar) do { unsigned _sp = 0; while (cond) { __builtin_amdgcn_s_sleep(1); \
    if ((++_sp & 255u) == 0u) { if (xb_ld(&(bar)[XB_TMO])) break; if (_sp > XB_SPIN_CAP) { atomicAdd(&(bar)[XB_TMO], 1u); break; } } } } while (0)
struct XcdBarrier { unsigned* bar; unsigned x; volatile LAS unsigned* st; };
__device__ __forceinline__ XcdBarrier xcd_barrier_post(unsigned* bar, volatile LAS unsigned* st) {
    XcdBarrier b; b.bar = bar; b.x = xb_xcc_id(); b.st = st;
    if (threadIdx.x == 0) (void)xb_add(&bar[XB_XCNT(b.x)], 1u);
    return b;
}
__device__ __forceinline__ void xcd_barrier_complete(unsigned* bar, unsigned x, unsigned& nloc, unsigned& nx) {
    const unsigned G = gridDim.x * gridDim.y * gridDim.z;
    unsigned sum, cnt, mine, sp = 0u;
    for (;;) {
        sum = 0u; cnt = 0u; mine = 0u;
#pragma unroll
        for (unsigned j = 0; j < 16; ++j) { const unsigned c = xb_ld(&bar[XB_XCNT(j)]); sum += c; cnt += (c > 0u) ? 1u : 0u; mine = (j == x) ? c : mine; }
        if (sum == G) break;
        __builtin_amdgcn_s_sleep(1);
        if ((++sp & 255u) == 0u) { if (xb_ld(&bar[XB_TMO])) break; if (sp > XB_SPIN_CAP) { atomicAdd(&bar[XB_TMO], 1u); break; } }
    }
    nloc = mine > 0u ? mine : 1u; nx = cnt > 0u ? cnt : 1u;
}
__device__ __forceinline__ void xcd_barrier(const XcdBarrier& b) {
    asm volatile("s_waitcnt vmcnt(0)" ::: "memory");
    __syncthreads();
    if (threadIdx.x == 0) {
        unsigned* bar = b.bar; unsigned bx = b.x; asm volatile("" : "+s"(bar), "+s"(bx));
        __builtin_amdgcn_s_waitcnt(0);
        unsigned nloc = b.st[0], nx = b.st[1];
        const unsigned old = xb_add(&bar[XB_XSUB(bx)], 1u);
        const unsigned gen = old / nloc;
        if (old + 1u == (gen + 1u) * nloc) {
            __builtin_amdgcn_fence(__ATOMIC_RELEASE, "agent");
            asm volatile("s_waitcnt vmcnt(0)" ::: "memory");
            const unsigned og = xb_add(&bar[XB_TOP], 1u);
            const unsigned tg = og / nx;
            if (og + 1u == (tg + 1u) * nx) xb_add(&bar[XB_TOPGEN], 1u);
            else XB_SPIN(xb_ld(&bar[XB_TOPGEN]) == tg, bar);
            __builtin_amdgcn_fence(__ATOMIC_ACQUIRE, "agent");
            xb_add(&bar[XB_XGEN(bx)], 1u);
            asm volatile("s_waitcnt vmcnt(0)" ::: "memory");
        } else {
            XB_SPIN(xb_ld(&bar[XB_XGEN(bx)]) == gen, bar);
            __builtin_amdgcn_fence(__ATOMIC_ACQUIRE, "agent");
            asm volatile("s_waitcnt vmcnt(0)" ::: "memory");
        }
    }
    __syncthreads();
}

constexpr int NB = 4, SEQ = 4096, MTOK = NB * SEQ, DM = 2048, DFF = 5632;
constexpr int N_AB = 7168, N_NSA = 5120;
constexpr int LDP_AB = N_AB + 64, LDP_NSA = N_NSA + 64;
constexpr int NWAVES = 8, NTHR = 512;
constexpr float EPS = 1e-6f;
constexpr float NEGF = -1e30f;

constexpr size_t MiB = 1u << 20;
constexpr size_t WS_CTL = 0;
constexpr size_t CTL_ZERO_BYTES = 1 * MiB;
constexpr size_t WS_WAB_IN  = 1 * MiB;
constexpr size_t WS_WAB_OUT = WS_WAB_IN + (size_t)2 * N_AB * DM * 2;
constexpr size_t WS_WNSA_IN = WS_WAB_OUT + (size_t)2 * DM * DM * 2;
constexpr size_t WS_WNSA_OUT = WS_WNSA_IN + (size_t)2 * N_NSA * DM * 2;
constexpr size_t WS_WAB_S = WS_WNSA_OUT + (size_t)2 * DM * DM * 2;
constexpr size_t WS_WNSA_S = WS_WAB_S + (size_t)2 * 16 * DM * 2;
constexpr size_t WS_WC1 = WS_WNSA_S + (size_t)2 * 48 * DM * 2;
constexpr size_t WS_WC2 = WS_WC1 + (size_t)4 * 256 * 4096 * 2;
constexpr size_t WS_WGU = WS_WC2 + (size_t)4 * 256 * 256 * 2;
constexpr size_t WS_WDN = WS_WGU + (size_t)4 * 2 * DFF * DM * 2;
constexpr size_t WS_CBIAS = WS_WDN + (size_t)4 * DM * DFF * 2;
constexpr size_t WS_ROPE = WS_CBIAS + 4096;
constexpr size_t WS_SG = WS_ROPE + (size_t)2 * SEQ * 64 * 4;
constexpr size_t WS_S0 = WS_SG + (size_t)64 * 2 * DFF * 4;
constexpr size_t WS_SMALL = WS_S0 + (size_t)64 * 4 * DFF * 4;
constexpr size_t WS_XN = WS_SMALL + (size_t)MTOK * 48 * 4;
constexpr size_t WS_MF = WS_XN + (size_t)MTOK * DM * 2;
constexpr size_t WS_SCR = WS_MF + (size_t)MTOK * DM * 4;
constexpr size_t SC_PROJ = 0;
constexpr size_t SC_ACT  = (size_t)MTOK * 2 * DFF * 2;
constexpr size_t SC_GOPS = (size_t)MTOK * LDP_AB * 2;
constexpr size_t GOP_BYTES = 90112;
constexpr size_t SC_GEG  = SC_GOPS + (size_t)2048 * GOP_BYTES;
constexpr size_t SC_GO   = SC_GEG + 8192;
constexpr size_t SC_Y    = SC_GO + (size_t)MTOK * 1024 * 4;
constexpr size_t SN_QR   = (size_t)MTOK * LDP_NSA * 2;
constexpr size_t SN_KC   = SN_QR + (size_t)MTOK * DM * 2;
constexpr size_t SN_VC   = SN_KC + (size_t)16 * SEQ * 128 * 2;
constexpr size_t SN_KS   = SN_VC + (size_t)16 * SEQ * 128 * 2 + 8192;
constexpr size_t SN_VS   = SN_KS + (size_t)16 * SEQ * 128 * 2;
constexpr size_t SN_KW   = SN_VS + (size_t)16 * SEQ * 128 * 2;
constexpr size_t SN_VW   = SN_KW + (size_t)16 * SEQ * 128 * 2;
constexpr size_t SN_GATE = SN_VW + (size_t)16 * SEQ * 128 * 2;
constexpr size_t SN_HCK  = SN_GATE + (size_t)MTOK * 48 * 4;
constexpr size_t SN_HCV  = SN_HCK + (size_t)4096 * 256 * 2;
constexpr size_t SN_KCF  = SN_HCV + (size_t)4096 * 256 * 2;
constexpr size_t SN_VCF  = SN_KCF + (size_t)16 * 32768 * 2;
constexpr size_t SN_SELM = SN_VCF + (size_t)16 * 32768 * 2;
constexpr size_t SN_YF   = SN_SELM + (size_t)16 * SEQ * 8;
constexpr size_t SN_END  = SN_YF + (size_t)MTOK * DM * 4;
static_assert(SN_END <= SC_Y, "odd-layer scratch must stay below Y");
constexpr size_t SCR_BYTES = SC_Y + (size_t)MTOK * DM * 2;
static_assert(SC_ACT + (size_t)MTOK * DFF * 2 <= SCR_BYTES, "ACT fits");
constexpr size_t WS_END = WS_SCR + SCR_BYTES;
constexpr int CW_BAR = 4096;

constexpr int LDS_BYTES = 155648;
constexpr int LDS_MISC = 155648 - 256;

struct Args { const float* in[20]; float* out; unsigned char* ws; int ph_lo, ph_hi; };

DI int map_col(int mode, int n, int c0, int drow0) { if (mode == 2) { const int isup = n >= DFF ? 1 : 0, ch = n - isup * DFF; return (ch >> 7) * 256 + isup * 128 + (ch & 127); } return drow0 + (n - c0); }
struct TJob { const float* W; int K, ldn, c0, nc; bf16* WT; int mode, drow0; };
DI void transpose_load(const TJob& J, int item, int lane, f32x4 (&v)[16]) {
    const int nblk = (J.nc + 63) / 64, kb = item / nblk, nb = item % nblk, k0 = 64 * kb, n0 = J.c0 + 64 * nb;
    const int nn = n0 + 4 * (lane & 15), kr = lane >> 4;
#pragma unroll
    for (int i = 0; i < 16; ++i) v[i] = nn < J.c0 + J.nc ? *(const f32x4*)(J.W + (size_t)(k0 + kr + 4 * i) * J.ldn + nn) : (f32x4){0.f, 0.f, 0.f, 0.f};
}
DI void transpose_store(const TJob& J, int item, int lane, const f32x4 (&v)[16], LAS float* scr) {
    const int nblk = (J.nc + 63) / 64, kb = item / nblk, nb = item % nblk, k0 = 64 * kb, n0 = J.c0 + 64 * nb, kr = lane >> 4;
#pragma unroll
    for (int i = 0; i < 16; ++i) { LAS float* d = scr + (kr + 4 * i) * 65 + 4 * (lane & 15); d[0] = v[i].x; d[1] = v[i].y; d[2] = v[i].z; d[3] = v[i].w; }
    asm volatile("s_waitcnt lgkmcnt(0)" ::: "memory");
    const int c = lane & 7;
#pragma unroll
    for (int j = 0; j < 8; ++j) { const int nl = (lane >> 3) + 8 * j; const LAS float* s = scr + (8 * c) * 65 + nl;
        u32x4 o; o.x = pk2(s[0 * 65], s[1 * 65]); o.y = pk2(s[2 * 65], s[3 * 65]); o.z = pk2(s[4 * 65], s[5 * 65]); o.w = pk2(s[6 * 65], s[7 * 65]);
        if (n0 + nl < J.c0 + J.nc) *(u32x4*)(J.WT + (size_t)map_col(J.mode, n0 + nl, J.c0, J.drow0) * J.K + k0 + 8 * c) = o; }
    asm volatile("s_waitcnt lgkmcnt(0)" ::: "memory");
}
DI void zero_fill16(void* p, size_t bytes, size_t gtid, size_t gthreads) { u32x4* q = (u32x4*)p; const u32x4 z = {0u, 0u, 0u, 0u}; for (size_t i = gtid; i < bytes / 16; i += gthreads) q[i] = z; }

DI void load_row(const float* p, int lane, f32x4 (&v)[8]) {
#pragma unroll
    for (int j = 0; j < 8; ++j) v[j] = ((const f32x4*)p)[lane + 64 * j];
}
DI float row_ss(const f32x4 (&v)[8]) { float s = 0.f;
#pragma unroll
    for (int j = 0; j < 8; ++j) s += (v[j].x * v[j].x + v[j].y * v[j].y) + (v[j].z * v[j].z + v[j].w * v[j].w);
    return wave_sum(s); }
DI void store_row_bf16_normed(bf16* o, int lane, const f32x4 (&v)[8], float r, const float* w) {
#pragma unroll
    for (int j = 0; j < 8; ++j) { const f32x4 ww = ((const f32x4*)w)[lane + 64 * j]; u32x2 q; q.x = pk2(v[j].x * r * ww.x, v[j].y * r * ww.y); q.y = pk2(v[j].z * r * ww.z, v[j].w * r * ww.w); ((u32x2*)o)[lane + 64 * j] = q; }
}
template <bool INF32>
DI void rowpass_t(int gw, int ngw, int lane, const bf16* MF, const float* Hf, const bf16* Hb, float* HOf, bf16* HOb, const float* wa, const float* wb, bf16* XN) {
    u32x2 mq[8], hq[8]; f32x4 hf[8];
    int row = gw;
    if (row < MTOK) {
#pragma unroll
        for (int j = 0; j < 8; ++j) { mq[j] = ((const u32x2*)(MF + (size_t)row * DM))[lane + 64 * j]; if (INF32) hf[j] = ((const f32x4*)(Hf + (size_t)row * DM))[lane + 64 * j]; else hq[j] = ((const u32x2*)(Hb + (size_t)row * DM))[lane + 64 * j]; }
    }
    for (; row < MTOK; row += ngw) {
        f32x4 v[8], h[8];
#pragma unroll
        for (int j = 0; j < 8; ++j) { v[j] = (f32x4){bflo(mq[j].x), bfhi(mq[j].x), bflo(mq[j].y), bfhi(mq[j].y)}; h[j] = INF32 ? hf[j] : (f32x4){bflo(hq[j].x), bfhi(hq[j].x), bflo(hq[j].y), bfhi(hq[j].y)}; }
        const int nrow = row + ngw;
        if (nrow < MTOK) {
#pragma unroll
            for (int j = 0; j < 8; ++j) { mq[j] = ((const u32x2*)(MF + (size_t)nrow * DM))[lane + 64 * j]; if (INF32) hf[j] = ((const f32x4*)(Hf + (size_t)nrow * DM))[lane + 64 * j]; else hq[j] = ((const u32x2*)(Hb + (size_t)nrow * DM))[lane + 64 * j]; }
        }
        const float r = 1.f / sqrtf(row_ss(v) * (1.f / DM) + EPS);
#pragma unroll
        for (int j = 0; j < 8; ++j) { const f32x4 ww = ((const f32x4*)wa)[lane + 64 * j]; h[j] = h[j] + v[j] * r * ww; }
        if (HOf) {
#pragma unroll
            for (int j = 0; j < 8; ++j) ((f32x4*)(HOf + (size_t)row * DM))[lane + 64 * j] = h[j];
        } else {
#pragma unroll
            for (int j = 0; j < 8; ++j) { u32x2 q; q.x = pk2(h[j].x, h[j].y); q.y = pk2(h[j].z, h[j].w); ((u32x2*)(HOb + (size_t)row * DM))[lane + 64 * j] = q; } }
        if (wb) { const float r2 = 1.f / sqrtf(row_ss(h) * (1.f / DM) + EPS); store_row_bf16_normed(XN + (size_t)row * DM, lane, h, r2, wb); }
    }
}
DI void rowpass(int gw, int ngw, int lane, const bf16* MF, const float* Hf, const bf16* Hb, float* HOf, bf16* HOb, const float* wa, const float* wb, bf16* XN) {
    if (Hf) rowpass_t<true>(gw, ngw, lane, MF, Hf, Hb, HOf, HOb, wa, wb, XN); else rowpass_t<false>(gw, ngw, lane, MF, Hf, Hb, HOf, HOb, wa, wb, XN);
}

DI void transpose_jobs(const Args& a, unsigned char* ws, LAS float* scr, int lane, int wi, int nw, int j0, int j1) {
    const int gw = wi, NGW = nw;
    for (int j = j0; j < j1; ++j) {
        TJob J; J.mode = 0; J.drow0 = 0; J.c0 = 0;
        if (j < 6)       { const int l = j / 3, w = j % 3; J.W = a.in[2] + (size_t)l * DM * 7184; J.K = DM; J.ldn = 7184;
                           if (w == 0) { J.c0 = 0; J.nc = 4096; J.WT = (bf16*)(ws + WS_WAB_IN) + (size_t)l * N_AB * DM; J.drow0 = 0; }
                           else if (w == 1) { J.c0 = 4112; J.nc = 3072; J.WT = (bf16*)(ws + WS_WAB_IN) + (size_t)l * N_AB * DM; J.drow0 = 4096; }
                           else { J.c0 = 4096; J.nc = 16; J.WT = (bf16*)(ws + WS_WAB_S) + (size_t)l * 16 * DM; J.drow0 = 0; } }
        else if (j < 8)  { J.W = a.in[3] + (size_t)(j - 6) * DM * DM; J.K = DM; J.ldn = DM; J.nc = DM; J.WT = (bf16*)(ws + WS_WAB_OUT) + (size_t)(j - 6) * DM * DM; }
        else if (j < 12) { const int l = (j - 8) >> 1, w = (j - 8) & 1; J.W = a.in[9] + (size_t)l * DM * 5168; J.K = DM; J.ldn = 5168;
                           if (w == 0) { J.nc = 5120; J.WT = (bf16*)(ws + WS_WNSA_IN) + (size_t)l * N_NSA * DM; }
                           else { J.c0 = 5120; J.nc = 48; J.WT = (bf16*)(ws + WS_WNSA_S) + (size_t)l * 48 * DM; } }
        else if (j < 14) { J.W = a.in[10] + (size_t)(j - 12) * DM * DM; J.K = DM; J.ldn = DM; J.nc = DM; J.WT = (bf16*)(ws + WS_WNSA_OUT) + (size_t)(j - 12) * DM * DM; }
        else if (j < 16) { J.W = a.in[12] + (size_t)(j - 14) * 4096 * 256; J.K = 4096; J.ldn = 256; J.nc = 256; J.WT = (bf16*)(ws + WS_WC1) + (size_t)((j - 14) * 2 + 0) * 256 * 4096; }
        else if (j < 18) { J.W = a.in[15] + (size_t)(j - 16) * 4096 * 256; J.K = 4096; J.ldn = 256; J.nc = 256; J.WT = (bf16*)(ws + WS_WC1) + (size_t)((j - 16) * 2 + 1) * 256 * 4096; }
        else if (j < 20) { J.W = a.in[13] + (size_t)(j - 18) * 256 * 128; J.K = 256; J.ldn = 128; J.nc = 128; J.WT = (bf16*)(ws + WS_WC2) + (size_t)((j - 18) * 2 + 0) * 256 * 256; }
        else if (j < 22) { J.W = a.in[16] + (size_t)(j - 20) * 256 * 128; J.K = 256; J.ldn = 128; J.nc = 128; J.WT = (bf16*)(ws + WS_WC2) + (size_t)((j - 20) * 2 + 1) * 256 * 256; }
        else if (j < 26) { J.W = a.in[17] + (size_t)(j - 22) * DM * 2 * DFF; J.K = DM; J.ldn = 2 * DFF; J.nc = 2 * DFF; J.WT = (bf16*)(ws + WS_WGU) + (size_t)(j - 22) * 2 * DFF * DM; J.mode = 2; }
        else             { J.W = a.in[19] + (size_t)(j - 26) * DFF * DM; J.K = DFF; J.ldn = DM; J.nc = DM; J.WT = (bf16*)(ws + WS_WDN) + (size_t)(j - 26) * DM * DFF; }
        const int nitems = (J.K / 64) * ((J.nc + 63) / 64);
        f32x4 va[16], vb[16];
        int it = gw;
        if (it < nitems) transpose_load(J, it, lane, va);
        while (it < nitems) {
            const int it1 = it + NGW, it2 = it + 2 * NGW;
            if (it1 < nitems) transpose_load(J, it1, lane, vb);
            transpose_store(J, it, lane, va, scr);
            if (it1 >= nitems) break;
            if (it2 < nitems) transpose_load(J, it2, lane, va);
            transpose_store(J, it1, lane, vb, scr);
            it = it2;
        }
    }
}

DI void p0_prologue(const Args& a, unsigned char* ws, LAS unsigned char* lds, int tid, int lane, int wave, int G, int blk) {
    LAS float* scr = (LAS float*)(lds + wave * 16640);
    const int gw = blk * NWAVES + wave, NGW = G * NWAVES;
    const size_t gtid = (size_t)blk * NTHR + tid, gthreads = (size_t)G * NTHR;
    transpose_jobs(a, ws, scr, lane, gw, NGW, 0, G == 256 ? 22 : 30);
    for (int q = 0; q < 4; ++q) zero_fill16((bf16*)(ws + WS_WC2) + ((size_t)q * 256 + 128) * 256, (size_t)128 * 256 * 2, gtid, gthreads);
    for (int o = gw; o < 1024; o += NGW) {
        const int q = o >> 8, n = o & 255, l = q >> 1, isv = q & 1;
        const float* pos = a.in[isv ? 14 : 11] + (size_t)l * 4096; const float* w1 = a.in[isv ? 15 : 12] + (size_t)l * 4096 * 256;
        float s = 0.f; for (int k = lane; k < 4096; k += 64) s += pos[k] * w1[(size_t)k * 256 + n];
        s = wave_sum(s); if (lane == 0) ((float*)(ws + WS_CBIAS))[o] = s;
    }
    for (size_t i = gtid; i < (size_t)SEQ * 64; i += gthreads) {
        const int t = (int)(i >> 6), f = (int)(i & 63);
        const float inv = exp2f(-(float)(2 * f) * (13.287712379549449f / 128.0f));
        const float ang = (float)t * inv;
        const float nrev = rintf(ang * 0.15915494309189535f); float r = fmaf(-nrev, 6.2831854820251465f, ang); r = fmaf(-nrev, -1.7484555e-7f, r);
        ((float*)(ws + WS_ROPE))[i] = cosf(r); ((float*)(ws + WS_ROPE))[(size_t)SEQ * 64 + i] = sinf(r);
    }
    const float* x = a.in[0]; const float* w00 = a.in[1];
    for (int row = gw; row < MTOK; row += NGW) {
        f32x4 v[8]; load_row(x + (size_t)row * DM, lane, v);
        const float r = 1.f / sqrtf(row_ss(v) * (1.f / DM) + EPS);
        store_row_bf16_normed((bf16*)(ws + WS_XN) + (size_t)row * DM, lane, v, r, w00);
    }
}

template <int NT> DI void narrow_gemm(LAS unsigned char* lds, int qp, int tid, const bf16* XN, const bf16* Ws, float* OUT) {
    const int lane = tid & 63, wave = tid >> 6, fr = lane & 15, fq = lane >> 4, rt = wave & 3, kh = wave >> 2, r0 = qp * 64 + 16 * rt;
    const bf16* a0 = XN + (size_t)(r0 + fr) * DM + kh * 1024 + 8 * fq; const bf16* bp = Ws + (size_t)fr * DM + kh * 1024 + 8 * fq;
    f32x4 acc[NT];
#pragma unroll
    for (int ct = 0; ct < NT; ++ct) acc[ct] = (f32x4){0.f, 0.f, 0.f, 0.f};
#pragma unroll 16
    for (int kk = 0; kk < 32; ++kk) {
        const bf16x8 A0 = *(const bf16x8*)(a0 + 32 * kk);
#pragma unroll
        for (int ct = 0; ct < NT; ++ct) { const bf16x8 B = *(const bf16x8*)(bp + (size_t)ct * 16 * DM + 32 * kk); acc[ct] = MFMA16(A0, B, acc[ct]); }
    }
    LAS f32x4* X = (LAS f32x4*)lds;
    if (kh == 1) {
#pragma unroll
        for (int ct = 0; ct < NT; ++ct) X[(rt * NT + ct) * 64 + lane] = acc[ct]; }
    __syncthreads();
    if (kh == 0) {
#pragma unroll
        for (int ct = 0; ct < NT; ++ct) { const f32x4 o = acc[ct] + X[(rt * NT + ct) * 64 + lane];
#pragma unroll
            for (int r = 0; r < 4; ++r) OUT[(size_t)(r0 + 4 * fq + r) * (16 * NT) + 16 * ct + fr] = o[r]; } }
    __syncthreads();
}

DI void gdn_prep(LAS unsigned char* lds, int tid_in, int lane_in, int wave, int G, int blk, const bf16* PROJ, const float* SMALL, const float* convw, const float* a_log, const float* dt_bias, unsigned char* ops, float* EG) {
    LAS float* LK = (LAS float*)(lds + 0);
    LAS float* SC = (LAS float*)(lds + 17408);
    LAS float* LQ = (LAS float*)(lds + 19456);
    LAS bf16* QR = (LAS bf16*)(lds + 36864);
    LAS bf16* KR = (LAS bf16*)(lds + 54272);
    LAS bf16* WB = (LAS bf16*)(lds + 71680);
    LAS bf16* XIN = (LAS bf16*)(lds + 89088);
    for (int item = blk; item < 2048; item += G) {
        int tid = tid_in; asm volatile("" : "+v"(tid)); const int lane = tid & 63, fr = lane & 15, fq = lane >> 4;
        const int b = item >> 9, h = (item >> 6) & 7, n = item & 63;
        const size_t row0 = (size_t)b * SEQ + (size_t)n * 64;
        unsigned char* op = ops + (size_t)item * GOP_BYTES;
        for (int e = tid; e < 67 * 48; e += NTHR) {
            const int r = e / 48, sgm = (e % 48) >> 4, ch = e & 15;
            u32x4 v = {0u, 0u, 0u, 0u};
            if (n > 0 || r >= 3) v = *(const u32x4*)(PROJ + (row0 + r - 3) * LDP_AB + sgm * 1024 + h * 128 + ch * 8);
            *(LAS u32x4*)(XIN + r * 384 + sgm * 128 + ch * 8) = v;
        }
        __syncthreads();
        float x[64];
        const int c = tid & 127;
        if (tid < 384) {
            const int which = tid < 128 ? 2 : (tid < 256 ? 1 : 0), col = which * 1024 + h * 128 + c;
            const float w0 = convw[col], w1 = convw[3072 + col], w2 = convw[6144 + col], w3 = convw[9216 + col];
            const LAS bf16* p = XIN + which * 128 + c;
            float x0 = bf2f(p[0]), x1 = bf2f(p[384]), x2 = bf2f(p[768]);
#pragma unroll
            for (int t = 0; t < 64; ++t) { const float x3 = bf2f(p[(t + 3) * 384]); x[t] = silu_f(w0 * x0 + w1 * x1 + w2 * x2 + w3 * x3); x0 = x1; x1 = x2; x2 = x3; }
            if (which != 2) { LAS bf16* dst = which == 1 ? KR : QR;
#pragma unroll
                for (int t = 0; t < 64; ++t) dst[t * 136 + c] = f2bf(x[t]); }
        } else if (tid < 448) {
            const int t = tid - 384; const float* p = SMALL + (row0 + t) * 16;
            const float av = p[h] + dt_bias[h], bv = p[8 + h];
            const float sp = fmaxf(av, 0.f) + __logf(1.f + __expf(-fabsf(av)));
            SC[t] = -__expf(a_log[h]) * sp; SC[64 + t] = sigmoid_f(bv);
        }
        __syncthreads();
        if (wave == 7) { float g = SC[lane];
#pragma unroll
            for (int o = 1; o < 64; o <<= 1) { const float t = __shfl_up(g, o); if (lane >= o) g += t; }
            SC[128 + lane] = g; }
#pragma unroll
        for (int i = 0; i < 4; ++i) {
            const int task = wave * 4 + i, mat = task >> 4, it = (task >> 2) & 3, jt = task & 3;
            if (it >= jt) {
                const LAS bf16* As = (mat ? QR : KR) + (16 * it + fr) * 136 + fq * 8; const LAS bf16* Bs = KR + (16 * jt + fr) * 136 + fq * 8;
                f32x4 acc = {0.f, 0.f, 0.f, 0.f};
#pragma unroll
                for (int kk = 0; kk < 4; ++kk) acc = MFMA16(*(const LAS bf16x8*)(As + kk * 32), *(const LAS bf16x8*)(Bs + kk * 32), acc);
                LAS float* dst = (mat ? LQ : LK) + (16 * it + 4 * fq) * 68 + 16 * jt + fr;
#pragma unroll
                for (int r = 0; r < 4; ++r) dst[r * 68] = acc[r];
            }
        }
        if (wave < 4) {
            const LAS bf16* As = QR + (16 * wave + fr) * 136 + fq * 8;
            f32x4 acc = {0.f, 0.f, 0.f, 0.f};
#pragma unroll
            for (int kk = 0; kk < 4; ++kk) { const bf16x8 av = *(const LAS bf16x8*)(As + kk * 32); acc = MFMA16(av, av, acc); }
#pragma unroll
            for (int r = 0; r < 4; ++r) if (fr == 4 * fq + r) SC[320 + 16 * wave + fr] = acc[r];
        }
        __syncthreads();
        if (tid < 64) { SC[192 + tid] = 1.f / sqrtf(LK[tid * 68 + tid] + EPS); SC[256 + tid] = 0.08838834764831845f / sqrtf(SC[320 + tid] + EPS); }
        __syncthreads();
        {
            bf16* QKf = (bf16*)(op + 49152);
#pragma unroll
            for (int k = 0; k < 8; ++k) {
                const int e = tid + 512 * k, i = e >> 6, j = e & 63;
                const float dec = (i >= j) ? __expf(SC[128 + i] - SC[128 + j]) : 0.f;
                const float lk = LK[i * 68 + j], lq = LQ[i * 68 + j];
                const float Lv = (i > j) ? SC[64 + i] * SC[192 + i] * SC[192 + j] * lk * dec : 0.f;
                const float qk = (i >= j) ? SC[256 + i] * SC[192 + j] * lq * dec : 0.f;
                LK[i * 68 + j] = Lv;
                QKf[(((i >> 4) * 2 + (j >> 5)) * 64 + ((j >> 2) & 3) * 16 + (i & 15)) * 8 + ((j >> 4) & 1) * 4 + (j & 3)] = f2bf(qk);
            }
        }
        __syncthreads();
        if (tid < 256) {
            if (tid < 128) {
#pragma unroll
                for (int i = 0; i < 64; ++i) x[i] *= SC[64 + i];
            } else {
#pragma unroll
                for (int i = 0; i < 64; ++i) x[i] *= SC[192 + i] * SC[64 + i] * __expf(SC[128 + i]);
            }
#pragma unroll
            for (int i = 1; i < 64; ++i) {
                float acc = x[i];
#pragma unroll
                for (int j = 0; j < i; ++j) acc -= LK[i * 68 + j] * x[j];
                x[i] = acc;
            }
            if (tid < 128) { f32x4* UT = (f32x4*)(op + 57344) + c;
#pragma unroll
                for (int i = 0; i < 16; ++i) UT[i * 128] = (f32x4){x[4 * i], x[4 * i + 1], x[4 * i + 2], x[4 * i + 3]};
            } else {
#pragma unroll
                for (int i = 0; i < 64; ++i) WB[i * 136 + c] = f2bf(x[i]);
            }
        } else {
            const int w4 = wave - 4;
            const float glast = SC[128 + 63];
#pragma unroll
            for (int i = 0; i < 4; ++i) {
                const int f = w4 * 4 + i, mt = f >> 2, kk = f & 3, tok = 16 * mt + fr;
                const float sc = SC[256 + tok] * __expf(SC[128 + tok]);
                const LAS bf16* s = QR + tok * 136 + 32 * kk + 4 * fq;
                const u32x2 lo = *(const LAS u32x2*)s, hi = *(const LAS u32x2*)(s + 16);
                u32x4 o; o.x = pk2(bflo(lo.x) * sc, bfhi(lo.x) * sc); o.y = pk2(bflo(lo.y) * sc, bfhi(lo.y) * sc); o.z = pk2(bflo(hi.x) * sc, bfhi(hi.x) * sc); o.w = pk2(bflo(hi.y) * sc, bfhi(hi.y) * sc);
                ((u32x4*)(op + 16384))[f * 64 + lane] = o;
            }
#pragma unroll
            for (int i = 0; i < 4; ++i) {
                const int f = w4 * 4 + i, dt = f >> 1, kk2 = f & 1, d = 16 * dt + fr;
                float v[8];
#pragma unroll
                for (int j = 0; j < 8; ++j) { const int tok = 32 * kk2 + 16 * (j >> 2) + 4 * fq + (j & 3); v[j] = bf2f(KR[tok * 136 + d]) * SC[192 + tok] * __expf(glast - SC[128 + tok]); }
                u32x4 o; o.x = pk2(v[0], v[1]); o.y = pk2(v[2], v[3]); o.z = pk2(v[4], v[5]); o.w = pk2(v[6], v[7]);
                ((u32x4*)(op + 32768))[f * 64 + lane] = o;
            }
            if (tid == 256) EG[item] = __expf(glast);
        }
        __syncthreads();
#pragma unroll
        for (int i = 0; i < 2; ++i) {
            const int f = wave * 2 + i, mt = f >> 2, kk = f & 3, tok = 16 * mt + fr;
            const LAS bf16* s = WB + tok * 136 + 32 * kk + 4 * fq;
            const u32x2 lo = *(const LAS u32x2*)s, hi = *(const LAS u32x2*)(s + 16);
            u32x4 o; o.x = lo.x; o.y = lo.y; o.z = hi.x; o.w = hi.y;
            ((u32x4*)op)[f * 64 + lane] = o;
        }
        __syncthreads();
    }
}

DI void gdn_scan(LAS unsigned char* lds, int tid, int lane, int wave, int G, int blk, const unsigned char* ops, const float* EG, float* O) {
    const int fr = lane & 15, fq = lane >> 4;
    for (int task = blk; task < 128; task += G) {
        const int xcd = task & 7, idx = task >> 3, bh = xcd + 8 * (idx >> 2), q4 = idx & 3, b = bh >> 3, h = bh & 7;
        const unsigned char* base0 = ops + (size_t)(bh * 64) * GOP_BYTES;
        const size_t utoff = 57344 + (size_t)(((tid >> 5) * 128 + q4 * 32 + (tid & 31)) * 16);
        u32x4 pr[8]; float eg = EG[bh * 64], egn = 0.f;
#pragma unroll
        for (int j = 0; j < 7; ++j) pr[j] = *(const u32x4*)(base0 + 16 * (tid + 512 * j));
        pr[7] = *(const u32x4*)(base0 + utoff);
#pragma unroll
        for (int j = 0; j < 8; ++j) *(LAS u32x4*)(lds + 16 * (tid + 512 * j)) = pr[j];
        __syncthreads();
        f32x4 S[8];
#pragma unroll
        for (int i = 0; i < 8; ++i) S[i] = (f32x4){0.f, 0.f, 0.f, 0.f};
        for (int n = 0; n < 64; ++n) {
            if (n + 1 < 64) {
                const unsigned char* bp = base0 + (size_t)(n + 1) * GOP_BYTES;
#pragma unroll
                for (int j = 0; j < 7; ++j) pr[j] = *(const u32x4*)(bp + 16 * (tid + 512 * j));
                pr[7] = *(const u32x4*)(bp + utoff);
                egn = EG[bh * 64 + n + 1];
            }
            if (wave < 2) {
                LAS unsigned char* L = lds + (n & 1) * 65536;
                const LAS bf16x8* Wf = (const LAS bf16x8*)L; const LAS bf16x8* Qf = (const LAS bf16x8*)(L + 16384); const LAS bf16x8* KDf = (const LAS bf16x8*)(L + 32768); const LAS bf16x8* QKf = (const LAS bf16x8*)(L + 49152);
                const LAS f32x4* UT = (const LAS f32x4*)(L + 57344);
                bf16x8 Sb[4];
#pragma unroll
                for (int kk = 0; kk < 4; ++kk) Sb[kk] = pack8(S[2 * kk], S[2 * kk + 1]);
                f32x4 vn[4];
#pragma unroll
                for (int mt = 0; mt < 4; ++mt) { f32x4 acc = {0.f, 0.f, 0.f, 0.f};
#pragma unroll
                    for (int kk = 0; kk < 4; ++kk) acc = MFMA16(Wf[(mt * 4 + kk) * 64 + lane], Sb[kk], acc);
                    vn[mt] = UT[(mt * 4 + fq) * 32 + 16 * wave + fr] - acc; }
                bf16x8 Vb[2]; Vb[0] = pack8(vn[0], vn[1]); Vb[1] = pack8(vn[2], vn[3]);
#pragma unroll
                for (int mt = 0; mt < 4; ++mt) { f32x4 acc = {0.f, 0.f, 0.f, 0.f};
#pragma unroll
                    for (int kk = 0; kk < 4; ++kk) acc = MFMA16(Qf[(mt * 4 + kk) * 64 + lane], Sb[kk], acc);
#pragma unroll
                    for (int k2 = 0; k2 < 2; ++k2) acc = MFMA16(QKf[(mt * 2 + k2) * 64 + lane], Vb[k2], acc);
                    float* o = O + ((size_t)b * SEQ + n * 64 + 16 * mt + 4 * fq) * 1024 + h * 128 + q4 * 32 + 16 * wave + fr;
#pragma unroll
                    for (int r = 0; r < 4; ++r) o[(size_t)r * 1024] = acc[r]; }
#pragma unroll
                for (int dt = 0; dt < 8; ++dt) { f32x4 acc = S[dt] * eg;
#pragma unroll
                    for (int k2 = 0; k2 < 2; ++k2) acc = MFMA16(KDf[(dt * 2 + k2) * 64 + lane], Vb[k2], acc);
                    S[dt] = acc; }
            }
            if (n + 1 < 64) {
                LAS unsigned char* Ln = lds + ((n + 1) & 1) * 65536;
#pragma unroll
                for (int j = 0; j < 8; ++j) *(LAS u32x4*)(Ln + 16 * (tid + 512 * j)) = pr[j];
            }
            eg = egn;
            __syncthreads();
        }
    }
}

struct GoutRow { f32x4 o[4]; u32x4 z[2], hb[2], gc[2], gb[2]; };
DI void gout_load(GoutRow& R, const float* O, const bf16* PROJ, size_t row, int lane) {
    const f32x4* op = (const f32x4*)(O + row * 1024 + lane * 16); const bf16* pr = PROJ + row * LDP_AB + lane * 16;
#pragma unroll
    for (int i = 0; i < 4; ++i) R.o[i] = op[i];
#pragma unroll
    for (int s = 0; s < 2; ++s) { R.z[s] = *(const u32x4*)(pr + 3072 + 8 * s); R.hb[s] = *(const u32x4*)(pr + 4096 + 8 * s); R.gb[s] = *(const u32x4*)(pr + 5120 + 8 * s); R.gc[s] = *(const u32x4*)(pr + 6144 + 8 * s); }
}
DI void unpack16(const u32x4 a, const u32x4 b, float (&f)[16]) {
    f[0] = bflo(a.x); f[1] = bfhi(a.x); f[2] = bflo(a.y); f[3] = bfhi(a.y); f[4] = bflo(a.z); f[5] = bfhi(a.z); f[6] = bflo(a.w); f[7] = bfhi(a.w);
    f[8] = bflo(b.x); f[9] = bfhi(b.x); f[10] = bflo(b.y); f[11] = bfhi(b.y); f[12] = bflo(b.z); f[13] = bfhi(b.z); f[14] = bflo(b.w); f[15] = bfhi(b.w);
}
DI void gdn_out(int gw, int ngw, int lane, const float* O, const bf16* PROJ, const float* onorm, const float* scw, bf16* Y) {
    float wn[16], w0[16], w1[16], w2[16];
#pragma unroll
    for (int i = 0; i < 16; ++i) { wn[i] = onorm[(lane & 7) * 16 + i]; w0[i] = scw[lane * 16 + i]; w1[i] = scw[1024 + lane * 16 + i]; w2[i] = scw[2048 + lane * 16 + i]; }
    for (int item = gw; item < MTOK / 8; item += ngw) {
        const size_t row0 = (size_t)item * 8; const int t0 = (int)(row0 & (SEQ - 1));
        float p1[16], p2[16];
#pragma unroll
        for (int i = 0; i < 16; ++i) { p1[i] = 0.f; p2[i] = 0.f; }
        if (t0 > 0) {
            const bf16* pa = PROJ + (row0 - 1) * LDP_AB + lane * 16; const bf16* pb = PROJ + (row0 - 2) * LDP_AB + lane * 16;
            float h[16], g[16];
            unpack16(*(const u32x4*)(pa + 4096), *(const u32x4*)(pa + 4096 + 8), h); unpack16(*(const u32x4*)(pa + 6144), *(const u32x4*)(pa + 6144 + 8), g);
#pragma unroll
            for (int i = 0; i < 16; ++i) p1[i] = h[i] * g[i];
            unpack16(*(const u32x4*)(pb + 4096), *(const u32x4*)(pb + 4096 + 8), h); unpack16(*(const u32x4*)(pb + 6144), *(const u32x4*)(pb + 6144 + 8), g);
#pragma unroll
            for (int i = 0; i < 16; ++i) p2[i] = h[i] * g[i];
        }
        GoutRow cur, nxt; gout_load(cur, O, PROJ, row0, lane);
#pragma unroll 1
        for (int rr = 0; rr < 8; ++rr) {
            const size_t row = row0 + rr;
            if (rr < 7) gout_load(nxt, O, PROJ, row + 1, lane);
            float ss = 0.f;
#pragma unroll
            for (int i = 0; i < 4; ++i) ss += (cur.o[i].x * cur.o[i].x + cur.o[i].y * cur.o[i].y) + (cur.o[i].z * cur.o[i].z + cur.o[i].w * cur.o[i].w);
            ss += __shfl_xor(ss, 1); ss += __shfl_xor(ss, 2); ss += __shfl_xor(ss, 4);
            const float r = 1.f / sqrtf(ss * (1.f / 128.f) + EPS);
            float zz[16], y[16]; unpack16(cur.z[0], cur.z[1], zz);
#pragma unroll
            for (int i = 0; i < 4; ++i) { y[4 * i] = cur.o[i].x * r * wn[4 * i] * silu_f(zz[4 * i]); y[4 * i + 1] = cur.o[i].y * r * wn[4 * i + 1] * silu_f(zz[4 * i + 1]);
                y[4 * i + 2] = cur.o[i].z * r * wn[4 * i + 2] * silu_f(zz[4 * i + 2]); y[4 * i + 3] = cur.o[i].w * r * wn[4 * i + 3] * silu_f(zz[4 * i + 3]); }
            u32x4 q0, q1; q0.x = pk2(y[0], y[1]); q0.y = pk2(y[2], y[3]); q0.z = pk2(y[4], y[5]); q0.w = pk2(y[6], y[7]); q1.x = pk2(y[8], y[9]); q1.y = pk2(y[10], y[11]); q1.z = pk2(y[12], y[13]); q1.w = pk2(y[14], y[15]);
            u32x4* yo = (u32x4*)(Y + row * DM + lane * 16); yo[0] = q0; yo[1] = q1;
            float h[16], g[16], gb[16]; unpack16(cur.hb[0], cur.hb[1], h); unpack16(cur.gc[0], cur.gc[1], g); unpack16(cur.gb[0], cur.gb[1], gb);
#pragma unroll
            for (int i = 0; i < 16; ++i) { const float p0 = h[i] * g[i]; y[i] = gb[i] * (w0[i] * p2[i] + w1[i] * p1[i] + w2[i] * p0); p2[i] = p1[i]; p1[i] = p0; }
            q0.x = pk2(y[0], y[1]); q0.y = pk2(y[2], y[3]); q0.z = pk2(y[4], y[5]); q0.w = pk2(y[6], y[7]); q1.x = pk2(y[8], y[9]); q1.y = pk2(y[10], y[11]); q1.z = pk2(y[12], y[13]); q1.w = pk2(y[14], y[15]);
            yo = (u32x4*)(Y + row * DM + 1024 + lane * 16); yo[0] = q0; yo[1] = q1;
            cur = nxt;
        }
    }
}

DI void ffn_fix(int gtid, int gthreads, const float* SG, const float* S0, const float* cw, bf16* ACT) {
    for (int e = gtid; e < 64 * 2 * (DFF / 4); e += gthreads) {
        const int c4 = e % (DFF / 4), pr = e / (DFF / 4), r = pr & 1, pm = pr >> 1, ch = 4 * c4;
        if ((pm & 15) == 0) continue;
        const f32x4 gm2 = *(const f32x4*)(SG + ((size_t)(pm - 1) * 2 + 0) * DFF + ch), gm1 = *(const f32x4*)(SG + ((size_t)(pm - 1) * 2 + 1) * DFF + ch);
        const f32x4 g0 = *(const f32x4*)(S0 + (((size_t)pm * 2 + 0) * 2) * DFF + ch), g1 = *(const f32x4*)(S0 + (((size_t)pm * 2 + 1) * 2) * DFF + ch);
        const f32x4 up = *(const f32x4*)(S0 + (((size_t)pm * 2 + r) * 2 + 1) * DFF + ch);
        const f32x4 w0 = *(const f32x4*)(cw + ch), w1 = *(const f32x4*)(cw + DFF + ch), w2 = *(const f32x4*)(cw + 2 * DFF + ch);
        const f32x4 c = r == 0 ? (w0 * gm2 + w1 * gm1 + w2 * g0) : (w0 * gm1 + w1 * g0 + w2 * g1);
        u32x2 o; o.x = pk2(silu_f(c.x) * up.x, silu_f(c.y) * up.y); o.y = pk2(silu_f(c.z) * up.z, silu_f(c.w) * up.w);
        *(u32x2*)(ACT + (size_t)(pm * 256 + r) * DFF + ch) = o;
    }
}

DI void ffn_act(int gw, int ngw, int lane, const bf16* GU, const float* cw, bf16* ACT) {
    for (int item = gw; item < (MTOK / 16) * 11; item += ngw) {
        const int rb = item / 11, cg = item % 11, c0 = cg * 512 + lane * 8, row0 = rb * 16, t0 = row0 & (SEQ - 1);
        float w[3][8];
#pragma unroll
        for (int k = 0; k < 3; ++k) { const f32x4 a = *(const f32x4*)(cw + k * DFF + c0), bq = *(const f32x4*)(cw + k * DFF + c0 + 4); w[k][0] = a.x; w[k][1] = a.y; w[k][2] = a.z; w[k][3] = a.w; w[k][4] = bq.x; w[k][5] = bq.y; w[k][6] = bq.z; w[k][7] = bq.w; }
        const bf16* g = GU + (size_t)row0 * (2 * DFF) + c0;
        u32x4 p0 = {0u, 0u, 0u, 0u}, p1 = {0u, 0u, 0u, 0u};
        if (t0 > 0) { p0 = *(const u32x4*)(g - (size_t)2 * (2 * DFF)); p1 = *(const u32x4*)(g - (size_t)(2 * DFF)); }
#pragma unroll 4
        for (int r = 0; r < 16; ++r) {
            const u32x4 p2 = *(const u32x4*)(g + (size_t)r * (2 * DFF)); const u32x4 up = *(const u32x4*)(g + (size_t)r * (2 * DFF) + DFF);
            float a[8];
            a[0] = w[0][0] * bflo(p0.x) + w[1][0] * bflo(p1.x) + w[2][0] * bflo(p2.x); a[1] = w[0][1] * bfhi(p0.x) + w[1][1] * bfhi(p1.x) + w[2][1] * bfhi(p2.x);
            a[2] = w[0][2] * bflo(p0.y) + w[1][2] * bflo(p1.y) + w[2][2] * bflo(p2.y); a[3] = w[0][3] * bfhi(p0.y) + w[1][3] * bfhi(p1.y) + w[2][3] * bfhi(p2.y);
            a[4] = w[0][4] * bflo(p0.z) + w[1][4] * bflo(p1.z) + w[2][4] * bflo(p2.z); a[5] = w[0][5] * bfhi(p0.z) + w[1][5] * bfhi(p1.z) + w[2][5] * bfhi(p2.z);
            a[6] = w[0][6] * bflo(p0.w) + w[1][6] * bflo(p1.w) + w[2][6] * bflo(p2.w); a[7] = w[0][7] * bfhi(p0.w) + w[1][7] * bfhi(p1.w) + w[2][7] * bfhi(p2.w);
            u32x4 o;
            o.x = pk2(silu_f(a[0]) * bflo(up.x), silu_f(a[1]) * bfhi(up.x)); o.y = pk2(silu_f(a[2]) * bflo(up.y), silu_f(a[3]) * bfhi(up.y));
            o.z = pk2(silu_f(a[4]) * bflo(up.z), silu_f(a[5]) * bfhi(up.z)); o.w = pk2(silu_f(a[6]) * bflo(up.w), silu_f(a[7]) * bfhi(up.w));
            *(u32x4*)(ACT + (size_t)(row0 + r) * DFF + c0) = o;
            p0 = p1; p1 = p2;
        }
    }
}

DI int kfrag_off(int t, int d) { return (t >> 6) * 8192 + ((((t >> 4) & 3) * 4 + (d >> 5)) * 64 + ((d >> 3) & 3) * 16 + (t & 15)) * 8 + (d & 7); }
DI int vfrag_off(int t, int d) { const int ck = t & 63; return (t >> 6) * 8192 + (((d >> 4) * 2 + (ck >> 5)) * 64 + ((ck >> 2) & 3) * 16 + (d & 15)) * 8 + ((ck >> 4) & 1) * 4 + (ck & 3); }
DI void rope8(const u32x4 a, const u32x4 bq, const float* cs, const float* sn, float scale, u32x4& o1, u32x4& o2) {
    const f32x4 c0 = *(const f32x4*)cs, c1 = *(const f32x4*)(cs + 4), s0 = *(const f32x4*)sn, s1 = *(const f32x4*)(sn + 4);
    const float x1[8] = {bflo(a.x), bfhi(a.x), bflo(a.y), bfhi(a.y), bflo(a.z), bfhi(a.z), bflo(a.w), bfhi(a.w)};
    const float x2[8] = {bflo(bq.x), bfhi(bq.x), bflo(bq.y), bfhi(bq.y), bflo(bq.z), bfhi(bq.z), bflo(bq.w), bfhi(bq.w)};
    const float c[8] = {c0.x, c0.y, c0.z, c0.w, c1.x, c1.y, c1.z, c1.w}, s[8] = {s0.x, s0.y, s0.z, s0.w, s1.x, s1.y, s1.z, s1.w};
    float y1[8], y2[8];
#pragma unroll
    for (int j = 0; j < 8; ++j) { y1[j] = (x1[j] * c[j] - x2[j] * s[j]) * scale; y2[j] = (x2[j] * c[j] + x1[j] * s[j]) * scale; }
    o1.x = pk2(y1[0], y1[1]); o1.y = pk2(y1[2], y1[3]); o1.z = pk2(y1[4], y1[5]); o1.w = pk2(y1[6], y1[7]);
    o2.x = pk2(y2[0], y2[1]); o2.y = pk2(y2[2], y2[3]); o2.z = pk2(y2[4], y2[5]); o2.w = pk2(y2[6], y2[7]);
}
DI void rope8v(const u32x4 a, const u32x4 bq, const f32x4 c0, const f32x4 c1, const f32x4 s0, const f32x4 s1, float scale, u32x4& o1, u32x4& o2) {
    const float x1[8] = {bflo(a.x), bfhi(a.x), bflo(a.y), bfhi(a.y), bflo(a.z), bfhi(a.z), bflo(a.w), bfhi(a.w)};
    const float x2[8] = {bflo(bq.x), bfhi(bq.x), bflo(bq.y), bfhi(bq.y), bflo(bq.z), bfhi(bq.z), bflo(bq.w), bfhi(bq.w)};
    const float c[8] = {c0.x, c0.y, c0.z, c0.w, c1.x, c1.y, c1.z, c1.w}, s[8] = {s0.x, s0.y, s0.z, s0.w, s1.x, s1.y, s1.z, s1.w};
    float y1[8], y2[8];
#pragma unroll
    for (int j = 0; j < 8; ++j) { y1[j] = (x1[j] * c[j] - x2[j] * s[j]) * scale; y2[j] = (x2[j] * c[j] + x1[j] * s[j]) * scale; }
    o1.x = pk2(y1[0], y1[1]); o1.y = pk2(y1[2], y1[3]); o1.z = pk2(y1[4], y1[5]); o1.w = pk2(y1[6], y1[7]);
    o2.x = pk2(y2[0], y2[1]); o2.y = pk2(y2[2], y2[3]); o2.z = pk2(y2[4], y2[5]); o2.w = pk2(y2[6], y2[7]);
}
DI void nsa_rope(LAS unsigned char* ldsw  , int gw, int ngw, int lane, const bf16* PROJ, const float* SMALL, const float* ROPE, unsigned char* scr) {
    bf16* QR = (bf16*)(scr + SN_QR); bf16* KC = (bf16*)(scr + SN_KC); bf16* VC = (bf16*)(scr + SN_VC);
    bf16* KS = (bf16*)(scr + SN_KS); bf16* VS = (bf16*)(scr + SN_VS); bf16* KW = (bf16*)(scr + SN_KW); bf16* VW = (bf16*)(scr + SN_VW);
    float* GATE = (float*)(scr + SN_GATE);
    const float* COSF = ROPE; const float* SINF = ROPE + (size_t)SEQ * 64;
    if (gw == 0) { u32x4* z = (u32x4*)(VC + (size_t)16 * SEQ * 128); const u32x4 zz = {0u, 0u, 0u, 0u}; for (int i = lane; i < 512; i += 64) z[i] = zz; }
    for (int item = gw; item < 2048; item += ngw) {
        const int tg = item >> 2, g = item & 3, row0 = tg * 32, b = row0 >> 12, t0 = row0 & (SEQ - 1); const size_t bg = (size_t)(b * 4 + g);
        const bf16* pr0 = PROJ + (size_t)row0 * LDP_NSA;
#pragma unroll 1
        for (int hb = 0; hb < 2; ++hb) {
            u32x4 xa[2][7], xb[2][7]; f32x4 cs[2][2], sn[2][2];
#pragma unroll
            for (int u = 0; u < 2; ++u) { const int pidx = (hb * 2 + u) * 64 + lane, dg = pidx & 7, tt = pidx >> 3, t = t0 + tt;
                const bf16* p = pr0 + (size_t)tt * LDP_NSA + 8 * dg;
                cs[u][0] = *(const f32x4*)(COSF + t * 64 + 8 * dg); cs[u][1] = *(const f32x4*)(COSF + t * 64 + 8 * dg + 4); sn[u][0] = *(const f32x4*)(SINF + t * 64 + 8 * dg); sn[u][1] = *(const f32x4*)(SINF + t * 64 + 8 * dg + 4);
#pragma unroll
                for (int s = 0; s < 7; ++s) { const int c0 = s < 4 ? (4 * g + s) * 128 : (2048 + (s - 4) * 1024 + g * 128); xa[u][s] = *(const u32x4*)(p + c0); xb[u][s] = *(const u32x4*)(p + c0 + 64); } }
#pragma unroll
            for (int u = 0; u < 2; ++u) { const int pidx = (hb * 2 + u) * 64 + lane, dg = pidx & 7, tt = pidx >> 3, t = t0 + tt;
#pragma unroll
                for (int s = 0; s < 7; ++s) { u32x4 o1, o2;
                    rope8v(xa[u][s], xb[u][s], cs[u][0], cs[u][1], sn[u][0], sn[u][1], s < 4 ? 0.12751743074602565f : 1.f, o1, o2);
                    if (s < 4) { bf16* d = QR + ((bg * SEQ + t) * 4 + s) * 128 + 8 * dg; *(u32x4*)d = o1; *(u32x4*)(d + 64) = o2; }
                    else if (s == 4) { bf16* d = KC + (bg * SEQ + t) * 128 + 8 * dg; *(u32x4*)d = o1; *(u32x4*)(d + 64) = o2; }
                    else { bf16* d = (s == 5 ? KS : KW) + bg * (SEQ * 128); *(u32x4*)(d + kfrag_off(t, 8 * dg)) = o1; *(u32x4*)(d + kfrag_off(t, 64 + 8 * dg)) = o2; } } }
        }
        {
            LAS bf16* TS = (LAS bf16*)ldsw; LAS bf16* TW = TS + 32 * 136;
            u32x4 vc[8], vs[8], vw[8]; float gt[24];
#pragma unroll
            for (int i = 0; i < 8; ++i) { const int idx = i * 64 + lane, ch = idx & 15, tt = idx >> 4; const bf16* src = pr0 + (size_t)tt * LDP_NSA + g * 128 + 8 * ch;
                vc[i] = *(const u32x4*)(src + 2560); vs[i] = *(const u32x4*)(src + 3584); vw[i] = *(const u32x4*)(src + 4608); }
            if (g == 0) {
#pragma unroll
                for (int i = 0; i < 24; ++i) gt[i] = SMALL[(size_t)row0 * 48 + i * 64 + lane]; }
#pragma unroll
            for (int i = 0; i < 8; ++i) { const int idx = i * 64 + lane, ch = idx & 15, tt = idx >> 4;
                *(u32x4*)(VC + (bg * SEQ + t0 + tt) * 128 + 8 * ch) = vc[i]; *(LAS u32x4*)(TS + tt * 136 + 8 * ch) = vs[i]; *(LAS u32x4*)(TW + tt * 136 + 8 * ch) = vw[i]; }
            if (g == 0) {
#pragma unroll
                for (int i = 0; i < 24; ++i) GATE[(size_t)row0 * 48 + i * 64 + lane] = sigmoid_f(gt[i]); }
            asm volatile("s_waitcnt lgkmcnt(0)" ::: "memory");
#pragma unroll 2
            for (int i = 0; i < 8; ++i) { const int q = i >> 1, d = (i & 1) * 64 + lane;
                bf16 es[8], ew[8];
#pragma unroll
                for (int j = 0; j < 8; ++j) { const int tt = 4 * q + 16 * (j >> 2) + (j & 3); es[j] = TS[tt * 136 + d]; ew[j] = TW[tt * 136 + d]; }
                u32x4 a, c; a.x = es[0] | ((unsigned)es[1] << 16); a.y = es[2] | ((unsigned)es[3] << 16); a.z = es[4] | ((unsigned)es[5] << 16); a.w = es[6] | ((unsigned)es[7] << 16);
                c.x = ew[0] | ((unsigned)ew[1] << 16); c.y = ew[2] | ((unsigned)ew[3] << 16); c.z = ew[4] | ((unsigned)ew[5] << 16); c.w = ew[6] | ((unsigned)ew[7] << 16);
                const int off = vfrag_off(t0 + 4 * q, d);
                *(u32x4*)(VS + bg * (SEQ * 128) + off) = a; *(u32x4*)(VW + bg * (SEQ * 128) + off) = c; }
            asm volatile("s_waitcnt lgkmcnt(0)" ::: "memory");
        }
    }
}

DI void nsa_cmp(LAS unsigned char* lds, int tid, int lane, int wave, int G, int blk, const unsigned char* scr, bf16* YC, unsigned long long* SELM) {
    const bf16* QR = (const bf16*)(scr + SN_QR); const bf16* KCF = (const bf16*)(scr + SN_KCF); const bf16* VCF = (const bf16*)(scr + SN_VCF); const float* GATE = (const float*)(scr + SN_GATE);
    LAS bf16* LK = (LAS bf16*)lds; LAS bf16* LV = (LAS bf16*)(lds + 65536); LAS float* SCL = (LAS float*)(lds + 131072);
    const int fr = lane & 15, fq = lane >> 4;
    for (int unit = blk; unit < 1024; unit += G) {
        const int bg = unit >> 6, qt = unit & 63, t0 = qt * 64, b = bg >> 2, g = bg & 3;
        const int cmax = (t0 + 32) >> 4; const int nblk = (cmax >> 6) + 1 < 4 ? (cmax >> 6) + 1 : 4;
        for (int i = tid; i < nblk * 1024; i += NTHR) { ((LAS u32x4*)LK)[i] = ((const u32x4*)(KCF + (size_t)bg * 32768))[i]; ((LAS u32x4*)LV)[i] = ((const u32x4*)(VCF + (size_t)bg * 32768))[i]; }
        __syncthreads();
#pragma unroll 1
        for (int nt = 0; nt < 2; ++nt) {
            const int tokbase = t0 + 8 * wave + 4 * nt;
            const bf16* qp = QR + (((size_t)bg * SEQ + tokbase) * 4 + fr) * 128 + 8 * fq;
            bf16x8 qf[4];
#pragma unroll
            for (int kk = 0; kk < 4; ++kk) qf[kk] = *(const bf16x8*)(qp + 32 * kk);
            f32x4 st[16];
#pragma unroll
            for (int tile = 0; tile < 16; ++tile) {
                f32x4 acc = {0.f, 0.f, 0.f, 0.f};
                if (tile < nblk * 4) {
#pragma unroll
                    for (int kk = 0; kk < 4; ++kk) acc = MFMA16(*(const LAS bf16x8*)(LK + (tile >> 2) * 8192 + (((tile & 3) * 4 + kk) * 64 + lane) * 8), qf[kk], acc);
                }
                st[tile] = acc;
            }
            const int t = tokbase + (fr >> 2);
            float m = NEGF;
#pragma unroll
            for (int tile = 0; tile < 16; ++tile)
#pragma unroll
                for (int r = 0; r < 4; ++r) { const int c = 16 * tile + 4 * fq + r; const bool valid = (tile < nblk * 4) && (16 * c + 31 <= t); const float s = valid ? st[tile][r] : NEGF; st[tile][r] = s; m = fmaxf(m, s); }
            m = quad_max(m);
            float l = 0.f;
#pragma unroll
            for (int tile = 0; tile < 16; ++tile)
#pragma unroll
                for (int r = 0; r < 4; ++r) { const float p = (st[tile][r] > -1e29f) ? __builtin_amdgcn_exp2f(st[tile][r] - m) : 0.f; st[tile][r] = p; l += p; }
            l = quad_sum(l);
            const float inv = l > 0.f ? 1.f / l : 0.f;
#pragma unroll
            for (int tile = 0; tile < 16; ++tile) st[tile] = st[tile] * inv;
#pragma unroll
            for (int tile = 0; tile < 16; ++tile) {
                const float prevtile3 = tile > 0 ? st[tile > 0 ? tile - 1 : 0][3] : 0.f;
                const float send = (fq == 3) ? prevtile3 : st[tile][3];
                const float prev = __shfl(send, (lane + 48) & 63);
                float sc = prev + 2.f * (st[tile][0] + st[tile][1] + st[tile][2]) + st[tile][3];
                sc += __shfl_xor(sc, 1); sc += __shfl_xor(sc, 2);
                if ((lane & 3) == 0) SCL[(wave * 8 + 4 * nt + (fr >> 2)) * 64 + 4 * tile + fq] = sc;
            }
            f32x4 ot[8];
#pragma unroll
            for (int dt = 0; dt < 8; ++dt) ot[dt] = (f32x4){0.f, 0.f, 0.f, 0.f};
#pragma unroll
            for (int k8 = 0; k8 < 8; ++k8) {
                if (k8 < nblk * 2) {
                    const bf16x8 pb = pack8(st[2 * k8], st[2 * k8 + 1]);
#pragma unroll
                    for (int dt = 0; dt < 8; ++dt) ot[dt] = MFMA16(*(const LAS bf16x8*)(LV + (k8 >> 1) * 8192 + ((dt * 2 + (k8 & 1)) * 64 + lane) * 8), pb, ot[dt]);
                }
            }
            const int head = fr & 3; const size_t row = (size_t)b * SEQ + t;
            const float gate = GATE[row * 48 + g * 4 + head];
            bf16* yo = YC + row * DM + (g * 4 + head) * 128 + 4 * fq;
#pragma unroll
            for (int dt = 0; dt < 8; ++dt) { const f32x4 y = ot[dt] * gate; u32x2 w; w.x = pk2(y.x, y.y); w.y = pk2(y.z, y.w); *(u32x2*)(yo + 16 * dt) = w; }
        }
        asm volatile("s_waitcnt lgkmcnt(0)" ::: "memory");
        {
            unsigned key[8], th[8];
#pragma unroll
            for (int u = 0; u < 8; ++u) {
                const int t = t0 + 8 * wave + u, n = lane, cur = t >> 6;
                const bool valid = (n * 64 <= t), forced = (n == 0) || (n == cur) || (n + 1 == cur);
                const float s = SCL[(wave * 8 + u) * 64 + lane] + (forced ? 1000.f : 0.f);
                key[u] = valid ? (__float_as_uint(fmaxf(s, 0.f)) + 1u) : 0u; th[u] = 0u;
            }
#pragma unroll 1
            for (int bit = 30; bit >= 0; --bit) {
#pragma unroll
                for (int u = 0; u < 8; ++u) { const unsigned c = th[u] | (1u << bit); th[u] = __popcll(__ballot(key[u] >= c)) >= 16 ? c : th[u]; }
            }
#pragma unroll
            for (int u = 0; u < 8; ++u) {
                const unsigned long long gt = __ballot(key[u] > th[u]), eq = __ballot(key[u] == th[u] && key[u] != 0u);
                const int need = 16 - __popcll(gt);
                const bool sel = (key[u] > th[u]) || (key[u] == th[u] && key[u] != 0u && __popcll(eq & ((1ull << lane) - 1ull)) < need);
                const unsigned long long mask = __ballot(sel);
                if (lane == 0) SELM[(size_t)bg * SEQ + t0 + 8 * wave + u] = mask;
            }
        }
        __syncthreads();
    }
}

DI void qk_tiles(const LAS bf16x8* Kb, int lane, const bf16x8 (&qf)[2][4], f32x4 (&st)[2][4]) {
    bf16x8 a0 = Kb[lane], a1 = Kb[64 + lane], b0 = Kb[128 + lane], b1 = Kb[192 + lane];
    __builtin_amdgcn_sched_group_barrier(0x100, 4, 0);
#pragma unroll
    for (int kt = 0; kt < 4; ++kt) {
        f32x4 acc0 = {0.f, 0.f, 0.f, 0.f}, acc1 = {0.f, 0.f, 0.f, 0.f};
#pragma unroll
        for (int kp = 0; kp < 2; ++kp) {
            const int s2 = kt * 2 + kp + 2;
            bf16x8 c0 = b0, c1 = b1;
            if (s2 < 8) { c0 = Kb[(s2 * 2) * 64 + lane]; c1 = Kb[(s2 * 2 + 1) * 64 + lane]; }
            acc0 = MFMA16(a0, qf[0][2 * kp], acc0); acc1 = MFMA16(a0, qf[1][2 * kp], acc1);
            acc0 = MFMA16(a1, qf[0][2 * kp + 1], acc0); acc1 = MFMA16(a1, qf[1][2 * kp + 1], acc1);
            if (s2 < 8) __builtin_amdgcn_sched_group_barrier(0x100, 2, 0);
            __builtin_amdgcn_sched_group_barrier(0x008, 4, 0);
            a0 = b0; a1 = b1; b0 = c0; b1 = c1;
        }
        st[0][kt] = acc0; st[1][kt] = acc1;
    }
}
template <int MODE>
DI void softmax_pv(const LAS bf16x8* Vb, int lane, int wave, int fr, int fq, int kb, int qt, int t0, unsigned long long sm0, unsigned long long sm1,
                   f32x4 (&st)[2][4], float (&m)[2], float (&l)[2], f32x4 (&ot)[2][8]) {
    const bool edge = MODE ? ((kb == qt) || (kb + 8 == qt)) : (kb == qt);
    constexpr float RESC_THR = 8.f;
    bf16x8 pb[2][2];
#pragma unroll
    for (int nt = 0; nt < 2; ++nt) {
        const int t = t0 + 8 * wave + 4 * nt + (fr >> 2);
        const bool colsel = MODE ? true : (((nt ? sm1 : sm0) >> kb) & 1ull) != 0ull;
        if (edge) {
#pragma unroll
            for (int kt = 0; kt < 4; ++kt)
#pragma unroll
                for (int r = 0; r < 4; ++r) { const int key = 64 * kb + 16 * kt + 4 * fq + r; const bool vis = key <= t && (MODE == 0 || key > t - 512); st[nt][kt][r] = vis ? st[nt][kt][r] : NEGF; }
        }
        float bm = quad_max(max16f(st[nt]));
        if (MODE == 0) bm = colsel ? bm : NEGF;
        if (__any(bm - m[nt] > RESC_THR)) {
            const float mnew = max2f(m[nt], bm);
            const float al = __builtin_amdgcn_exp2f(max2f(m[nt], -1e20f) - max2f(mnew, -1e20f));
            l[nt] *= al; m[nt] = mnew;
#pragma unroll
            for (int dt = 0; dt < 8; ++dt) scale_inplace(ot[nt][dt], al);
        }
        const float mexp = (MODE == 0 && !colsel) ? 1e30f : max2f(m[nt], -1e20f);
        const f32x2 mexp2 = {mexp, mexp};
#pragma unroll
        for (int kt = 0; kt < 4; ++kt) { const f32x2 dl = sub_pk((f32x2){st[nt][kt][0], st[nt][kt][1]}, mexp2), dh = sub_pk((f32x2){st[nt][kt][2], st[nt][kt][3]}, mexp2); st[nt][kt] = (f32x4){__builtin_amdgcn_exp2f(dl[0]), __builtin_amdgcn_exp2f(dl[1]), __builtin_amdgcn_exp2f(dh[0]), __builtin_amdgcn_exp2f(dh[1])}; }
        const f32x4 s4 = (st[nt][0] + st[nt][1]) + (st[nt][2] + st[nt][3]);
        l[nt] += quad_sum((s4[0] + s4[1]) + (s4[2] + s4[3]));
        pb[nt][0] = pack8(st[nt][0], st[nt][1]); pb[nt][1] = pack8(st[nt][2], st[nt][3]);
    }
    {
        bf16x8 v0 = Vb[lane], v1 = Vb[64 + lane], w0 = Vb[128 + lane], w1 = Vb[192 + lane];
        __builtin_amdgcn_sched_group_barrier(0x100, 4, 0);
#pragma unroll
        for (int dt = 0; dt < 8; ++dt) {
            bf16x8 x0 = w0, x1 = w1;
            if (dt < 6) { x0 = Vb[((dt + 2) * 2 + 0) * 64 + lane]; x1 = Vb[((dt + 2) * 2 + 1) * 64 + lane]; }
#pragma unroll
            for (int nt = 0; nt < 2; ++nt) { f32x4 o = ot[nt][dt]; o = MFMA16(v0, pb[nt][0], o); o = MFMA16(v1, pb[nt][1], o); ot[nt][dt] = o; }
            if (dt < 6) __builtin_amdgcn_sched_group_barrier(0x100, 2, 0);
            __builtin_amdgcn_sched_group_barrier(0x008, 4, 0);
            v0 = w0; v1 = w1; w0 = x0; w1 = x1;
        }
    }
}
DI void pv_only(const LAS bf16x8* Vb, int lane, f32x4 (&st)[2][4], f32x4 (&ot)[2][8]) {
    bf16x8 pb[2][2];
#pragma unroll
    for (int nt = 0; nt < 2; ++nt) { pb[nt][0] = pack8(st[nt][0], st[nt][1]); pb[nt][1] = pack8(st[nt][2], st[nt][3]); }
#pragma unroll
    for (int dt = 0; dt < 8; ++dt) { const bf16x8 v0 = Vb[(dt * 2 + 0) * 64 + lane], v1 = Vb[(dt * 2 + 1) * 64 + lane];
#pragma unroll
        for (int nt = 0; nt < 2; ++nt) { f32x4 o = ot[nt][dt]; o = MFMA16(v0, pb[nt][0], o); o = MFMA16(v1, pb[nt][1], o); ot[nt][dt] = o; } }
}
template <int MODE>
DI void softmax_only(int lane, int wave, int fr, int fq, int kb, int qt, int t0, unsigned long long sm0, unsigned long long sm1, f32x4 (&st)[2][4], float (&m)[2], float (&l)[2], f32x4 (&ot)[2][8]) {
    constexpr float RESC_THR = 8.f;
#pragma unroll
    for (int nt = 0; nt < 2; ++nt) {
        const bool colsel = MODE ? true : (((nt ? sm1 : sm0) >> kb) & 1ull) != 0ull;
        float bm = quad_max(max16f(st[nt]));
        if (MODE == 0) bm = colsel ? bm : NEGF;
        if (__any(bm - m[nt] > RESC_THR)) { const float mnew = fmaxf(m[nt], bm); const float al = __builtin_amdgcn_exp2f(fmaxf(m[nt], -1e20f) - fmaxf(mnew, -1e20f)); l[nt] *= al; m[nt] = mnew;
#pragma unroll
            for (int dt = 0; dt < 8; ++dt) ot[nt][dt] = ot[nt][dt] * al; }
        const float mexp = (MODE == 0 && !colsel) ? 1e30f : fmaxf(m[nt], -1e20f);
#pragma unroll
        for (int kt = 0; kt < 4; ++kt) { const f32x4 d = st[nt][kt] - mexp; st[nt][kt] = (f32x4){__builtin_amdgcn_exp2f(d[0]), __builtin_amdgcn_exp2f(d[1]), __builtin_amdgcn_exp2f(d[2]), __builtin_amdgcn_exp2f(d[3])}; }
        const f32x4 s4 = (st[nt][0] + st[nt][1]) + (st[nt][2] + st[nt][3]);
        l[nt] += quad_sum((s4[0] + s4[1]) + (s4[2] + s4[3]));
        const bf16x8 p0 = pack8(st[nt][0], st[nt][1]), p1 = pack8(st[nt][2], st[nt][3]);
        ot[nt][0][0] += __builtin_bit_cast(f32x4, p0)[0] * 1e-30f + __builtin_bit_cast(f32x4, p1)[1] * 1e-30f;
    }
}
template <int MODE, int SLOT, int DRY>
DI void block_step(LAS unsigned char* lds, int lane, int wave, int fr, int fq, const u32x4* kg, const u32x4* vg, int i, int kb0, int nkb, int qt, int t0,
                   const bf16x8 (&qf)[2][4], unsigned long long sm0, unsigned long long sm1, unsigned long long wneed, float (&m)[2], float (&l)[2], f32x4 (&ot)[2][8]) {
    asm volatile("s_waitcnt vmcnt(0)" ::: "memory");
    __syncthreads();
    if (i + 1 < nkb) {
#pragma unroll
        for (int j = 0; j < 2; ++j) { const int pc = wave * 2 + j;
            __builtin_amdgcn_global_load_lds((const unsigned*)(kg + (i + 1) * 1024 + pc * 64 + lane), (LAS unsigned*)(lds + (1 - SLOT) * 32768 + pc * 1024), 16, 0, 0);
            __builtin_amdgcn_global_load_lds((const unsigned*)(vg + (i + 1) * 1024 + pc * 64 + lane), (LAS unsigned*)(lds + (1 - SLOT) * 32768 + 16384 + pc * 1024), 16, 0, 0); } }
    const int kb = kb0 + i;
    if (MODE == 0 && !((wneed >> kb) & 1ull)) return;
    f32x4 st[2][4];
    if (DRY == 3) return;
    if (DRY == 2) {
#pragma unroll
        for (int nt = 0; nt < 2; ++nt)
#pragma unroll
            for (int kt = 0; kt < 4; ++kt) st[nt][kt] = (f32x4){0.f, 0.25f, 0.5f, 0.75f} + (float)(lane & 7);
        softmax_only<MODE>(lane, wave, fr, fq, kb, qt, t0, sm0, sm1, st, m, l, ot);
        return; }
    qk_tiles((const LAS bf16x8*)(lds + SLOT * 32768), lane, qf, st);
    if (DRY == 1) { pv_only((const LAS bf16x8*)(lds + SLOT * 32768 + 16384), lane, st, ot); return; }
    softmax_pv<MODE>((const LAS bf16x8*)(lds + SLOT * 32768 + 16384), lane, wave, fr, fq, kb, qt, t0, sm0, sm1, st, m, l, ot);
}
template <int MODE, int DRY>
DI void block_pass(LAS unsigned char* lds, int tid, int lane, int wave, int fr, int fq, const u32x4* kg, const u32x4* vg, int kb0, int nkb, int qt, int t0,
                   const bf16x8 (&qf)[2][4], unsigned long long sm0, unsigned long long sm1, unsigned long long wneed, float (&m)[2], float (&l)[2], f32x4 (&ot)[2][8]) {
#pragma unroll
    for (int j = 0; j < 2; ++j) { const int pc = wave * 2 + j;
        __builtin_amdgcn_global_load_lds((const unsigned*)(kg + pc * 64 + lane), (LAS unsigned*)(lds + pc * 1024), 16, 0, 0);
        __builtin_amdgcn_global_load_lds((const unsigned*)(vg + pc * 64 + lane), (LAS unsigned*)(lds + 16384 + pc * 1024), 16, 0, 0); }
    for (int i = 0; i < nkb; i += 2) {
        block_step<MODE, 0, DRY>(lds, lane, wave, fr, fq, kg, vg, i, kb0, nkb, qt, t0, qf, sm0, sm1, wneed, m, l, ot);
        if (i + 1 < nkb) block_step<MODE, 1, DRY>(lds, lane, wave, fr, fq, kg, vg, i + 1, kb0, nkb, qt, t0, qf, sm0, sm1, wneed, m, l, ot);
    }
}
#ifndef DRYMODE
#define DRYMODE 0
#endif
template <int DRY>
DI void nsa_selwin(LAS unsigned char* lds, int tid, int lane, int wave, int G, int blk, const unsigned char* scr, const bf16* YC, bf16* Y) {
    const bf16* QR = (const bf16*)(scr + SN_QR); const float* GATE = (const float*)(scr + SN_GATE);
    const bf16* KS = (const bf16*)(scr + SN_KS); const bf16* VS = (const bf16*)(scr + SN_VS); const bf16* KW = (const bf16*)(scr + SN_KW); const bf16* VW = (const bf16*)(scr + SN_VW);
    const unsigned long long* SELM = (const unsigned long long*)(scr + SN_SELM);
    LAS u32x2* STASH = (LAS u32x2*)(lds + 65536) + wave * 1024;
    const int fr = lane & 15, fq = lane >> 4;
    for (int pu = 2 * blk; pu < 1024; pu += (pu & 1) ? 2 * G - 1 : 1) {
        int pi = pu >> 1; const int half = pu & 1;
        if (G == 256) { const int rr = pi >> 8, bx = pi & 255; pi = ((2 * (bx & 7) + rr) << 5) | (bx >> 3); }
        const int bg = pi >> 5, jj = pi & 31, qt = half ? 63 - jj : jj;
        const int t0 = qt * 64, b = bg >> 2, g = bg & 3;
        bf16x8 qf[2][4];
#pragma unroll
        for (int nt = 0; nt < 2; ++nt)
#pragma unroll
            for (int kk = 0; kk < 4; ++kk) qf[nt][kk] = *(const bf16x8*)(QR + (((size_t)bg * SEQ + t0 + 8 * wave + 4 * nt) * 4 + fr) * 128 + 32 * kk + 8 * fq);
        const unsigned long long sm0 = SELM[(size_t)bg * SEQ + t0 + 8 * wave + (fr >> 2)], sm1 = SELM[(size_t)bg * SEQ + t0 + 8 * wave + 4 + (fr >> 2)];
        unsigned lo = (unsigned)(sm0 | sm1), hi = (unsigned)((sm0 | sm1) >> 32);
#pragma unroll
        for (int o = 1; o < 64; o <<= 1) { lo |= (unsigned)__shfl_xor((int)lo, o); hi |= (unsigned)__shfl_xor((int)hi, o); }
        const unsigned long long wneed = ((unsigned long long)(unsigned)__builtin_amdgcn_readfirstlane((int)hi) << 32) | (unsigned)__builtin_amdgcn_readfirstlane((int)lo);
        float m[2] = {NEGF, NEGF}, l[2] = {0.f, 0.f};
        f32x4 ot[2][8];
#pragma unroll
        for (int nt = 0; nt < 2; ++nt)
#pragma unroll
            for (int dt = 0; dt < 8; ++dt) ot[nt][dt] = (f32x4){0.f, 0.f, 0.f, 0.f};
        block_pass<0, DRY>(lds, tid, lane, wave, fr, fq, (const u32x4*)(KS + (size_t)bg * 64 * 8192), (const u32x4*)(VS + (size_t)bg * 64 * 8192), 0, qt + 1, qt, t0, qf, sm0, sm1, wneed, m, l, ot);
#pragma unroll
        for (int nt = 0; nt < 2; ++nt) {
            const int t = t0 + 8 * wave + 4 * nt + (fr >> 2), head = fr & 3; const size_t row = (size_t)b * SEQ + t;
            const float sc = GATE[row * 48 + 16 + g * 4 + head] / l[nt];
#pragma unroll
            for (int dt = 0; dt < 8; ++dt) { const f32x4 y = ot[nt][dt] * sc; u32x2 w; w.x = pk2(y.x, y.y); w.y = pk2(y.z, y.w); STASH[(nt * 8 + dt) * 64 + lane] = w; ot[nt][dt] = (f32x4){0.f, 0.f, 0.f, 0.f}; }
            m[nt] = NEGF; l[nt] = 0.f;
        }
        __syncthreads();
        const int kb0 = qt >= 8 ? qt - 8 : 0;
        block_pass<1, DRY>(lds, tid, lane, wave, fr, fq, (const u32x4*)(KW + ((size_t)bg * 64 + kb0) * 8192), (const u32x4*)(VW + ((size_t)bg * 64 + kb0) * 8192), kb0, qt - kb0 + 1, qt, t0, qf, 0ull, 0ull, 0ull, m, l, ot);
#pragma unroll
        for (int nt = 0; nt < 2; ++nt) {
            const int t = t0 + 8 * wave + 4 * nt + (fr >> 2), head = fr & 3; const size_t row = (size_t)b * SEQ + t;
            const float sc = GATE[row * 48 + 32 + g * 4 + head] / l[nt];
            const size_t off = row * DM + (g * 4 + head) * 128 + 4 * fq;
#pragma unroll
            for (int dt = 0; dt < 8; ++dt) { const u32x2 c = *(const u32x2*)(YC + off + 16 * dt), s2 = STASH[(nt * 8 + dt) * 64 + lane];
                const f32x4 y = ot[nt][dt] * sc + (f32x4){bflo(c.x) + bflo(s2.x), bfhi(c.x) + bfhi(s2.x), bflo(c.y) + bflo(s2.y), bfhi(c.y) + bfhi(s2.y)};
                u32x2 w; w.x = pk2(y.x, y.y); w.y = pk2(y.z, y.w); *(u32x2*)(Y + off + 16 * dt) = w; }
        }
        __syncthreads();
    }
}

#ifndef MK_MULTI
#define MK_MULTI 0
#endif
constexpr int PH_PER_LAYER = 13, NPHASE = 1 + 4 * PH_PER_LAYER;

template <class Epi> DI void run_gemm(LAS unsigned char* lds, const bf16* A, int lda, const bf16* Bt, int ldb, int M, int N, int K, const Epi& E, int G, int c, int tid) {
#ifdef GEMM_STAGGER
    if (N >= 4096) { for (int i = 0; i < (c & 3); ++i) __builtin_amdgcn_s_sleep(GEMM_STAGGER); }
#endif
    pg8::Gemm g{A, Bt, M, N, K, lda, ldb}; pg8::StaticOrder S; S.init(M, N, G, c);
    #ifndef GEMM_ALIGN
#define GEMM_ALIGN true
#endif
#ifndef GEMM_SP2
#define GEMM_SP2 true
#endif
    pg8::gemm_phase<Epi, pg8::StaticOrder, GEMM_ALIGN, GEMM_SP2>(lds, g, S, E, tid);
}

__global__ void __launch_bounds__(NTHR, 2) fwd_kernel(Args a) {
    extern __shared__ __attribute__((aligned(16))) unsigned char lds_raw[];
    LAS unsigned char* lds = (LAS unsigned char*)lds_raw;
    const int tid0 = threadIdx.x;
    const int G = gridDim.x, blk0 = blockIdx.x;
#define LAUNDER int tid = tid0, blk = blk0; asm volatile("" : "+v"(tid), "+s"(blk)); const int lane = tid & 63, wave = __builtin_amdgcn_readfirstlane(tid >> 6), gw = blk * NWAVES + wave, ngw = G * NWAVES; (void)lane; (void)wave; (void)gw; (void)ngw;
    unsigned char* ws = a.ws;
    volatile LAS unsigned* MISC = (volatile LAS unsigned*)(lds + LDS_MISC);
    if (tid0 < 64) MISC[tid0] = 0u;
    __syncthreads();
    XcdBarrier bar; bar.bar = (unsigned*)(ws + WS_CTL) + CW_BAR; bar.x = 0; bar.st = nullptr;
    if (!MK_MULTI) {
        bar = xcd_barrier_post((unsigned*)(ws + WS_CTL) + CW_BAR, MISC + 8);
        if (tid0 == 0) { unsigned nloc, nx; xcd_barrier_complete(bar.bar, bar.x, nloc, nx); MISC[8] = nloc; MISC[9] = nx; }
        __syncthreads();
    }
    const int lo = a.ph_lo, hi = a.ph_hi;
#ifndef ONLY
#define ONLY -1
#endif
#define SEL(id) (ONLY < 0 || ONLY == (id))
#ifndef REPID
#define REPID -1
#endif
#ifndef REPID2
#define REPID2 -1
#endif
#ifndef REPPAIR
#define REPPAIR 1
#endif
#define NREP(id) ((REPID == (id) || REPID2 == (id)) ? 2 : 1)
#define PH(k) (lo <= (k) && (k) < hi)
#define END(k) do { if (!MK_MULTI && (k) + 1 < hi) xcd_barrier(bar); } while (0)

    unsigned char* scr = ws + WS_SCR;
    bf16* XN = (bf16*)(ws + WS_XN); bf16* MF = (bf16*)(ws + WS_MF); bf16* HB = (bf16*)(ws + WS_MF) + (size_t)MTOK * DM; float* H = a.out;
    bf16* Y = (bf16*)(scr + SC_Y);
    const float* nw = a.in[1];

    if (SEL(0) && PH(0)) { for (int rep_ = 0; rep_ < NREP(0); ++rep_) { LAUNDER p0_prologue(a, ws, lds, tid, lane, wave, G, blk); END(0); } }

#pragma unroll 1
    for (int l = 0; l < 4; ++l) {
        const int pb = 1 + l * PH_PER_LAYER, li = l >> 1;
        if ((l & 1) == 0) {
            bf16* PROJ = (bf16*)(scr + SC_PROJ);
            if (SEL(1) && PH(pb + 0)) { for (int rep_ = 0; rep_ < NREP(1); ++rep_) { LAUNDER pg8::EpiBf16<0> E{PROJ, LDP_AB, nullptr}; run_gemm(lds, XN, DM, (const bf16*)(ws + WS_WAB_IN) + (size_t)li * N_AB * DM, DM, MTOK, N_AB, DM, E, G, blk, tid); for (int qp = blk; qp < 256; qp += G) narrow_gemm<1>(lds, qp, tid, XN, (const bf16*)(ws + WS_WAB_S) + (size_t)li * 16 * DM, (float*)(ws + WS_SMALL)); END(pb + 0); } }
            if (SEL(2) && PH(pb + 1)) { for (int rep_ = 0; rep_ < NREP(2); ++rep_) { LAUNDER gdn_prep(lds, tid, lane, wave, G, blk, PROJ, (const float*)(ws + WS_SMALL), a.in[4] + (size_t)li * 4 * 3072, a.in[5] + li * 8, a.in[6] + li * 8, scr + SC_GOPS, (float*)(scr + SC_GEG)); END(pb + 1); } }
            if (SEL(3) && PH(pb + 2)) { for (int rep_ = 0; rep_ < NREP(3); ++rep_) { LAUNDER gdn_scan(lds, tid, lane, wave, G, blk, scr + SC_GOPS, (const float*)(scr + SC_GEG), (float*)(scr + SC_GO)); if (G == 256 && blk >= 128 && rep_ == 0) { transpose_jobs(a, ws, (LAS float*)(lds + wave * 16640), lane, (blk - 128) * NWAVES + wave, 128 * NWAVES, 22 + l, 23 + l); transpose_jobs(a, ws, (LAS float*)(lds + wave * 16640), lane, (blk - 128) * NWAVES + wave, 128 * NWAVES, 26 + l, 27 + l); } END(pb + 2); } }
            if (SEL(4) && PH(pb + 3)) { for (int rep_ = 0; rep_ < NREP(4); ++rep_) { LAUNDER gdn_out(gw, ngw, lane, (const float*)(scr + SC_GO), PROJ, a.in[7] + li * 128, a.in[8] + (size_t)li * 3 * 1024, Y); END(pb + 3); } }
            if (SEL(5) && PH(pb + 4)) { for (int rep_ = 0; rep_ < NREP(5); ++rep_) { LAUNDER pg8::EpiBf16<0> E{MF, DM, nullptr}; run_gemm(lds, Y, DM, (const bf16*)(ws + WS_WAB_OUT) + (size_t)li * DM * DM, DM, MTOK, DM, DM, E, G, blk, tid); END(pb + 4); } }
        } else {
            bf16* PROJ = (bf16*)(scr + SC_PROJ);
            if (SEL(21) && PH(pb + 0)) { for (int rep_ = 0; rep_ < NREP(21); ++rep_) { LAUNDER pg8::EpiBf16<0> E{PROJ, LDP_NSA, nullptr}; run_gemm(lds, XN, DM, (const bf16*)(ws + WS_WNSA_IN) + (size_t)li * N_NSA * DM, DM, MTOK, N_NSA, DM, E, G, blk, tid); for (int qp = blk; qp < 256; qp += G) narrow_gemm<3>(lds, qp, tid, XN, (const bf16*)(ws + WS_WNSA_S) + (size_t)li * 48 * DM, (float*)(ws + WS_SMALL)); END(pb + 0); } }
            if (SEL(22) && PH(pb + 1)) { for (int rep_ = 0; rep_ < NREP(22); ++rep_) { LAUNDER nsa_rope(lds + wave * 17408, gw, ngw, lane, PROJ, (const float*)(ws + WS_SMALL), (const float*)(ws + WS_ROPE), scr); END(pb + 1); } }
            if (SEL(23) && PH(pb + 2)) { for (int rep_ = 0; rep_ < NREP(23); ++rep_) { LAUNDER
                const int isv = blk >= 16 ? 1 : 0, c = blk < 32 ? (blk & 15) : -1;
                pg8::EpiBf16<1> E{(bf16*)(scr + (isv ? SN_HCV : SN_HCK)), 256, (const float*)(ws + WS_CBIAS) + (li * 2 + isv) * 256};
                run_gemm(lds, (const bf16*)(scr + (isv ? SN_VC : SN_KC)), 2048, (const bf16*)(ws + WS_WC1) + (size_t)(li * 2 + isv) * 256 * 4096, 4096, 4096, 256, 4096, E, 16, c, tid);
                if (G == 256 && blk >= 32 && rep_ == 0) { transpose_jobs(a, ws, (LAS float*)(lds + wave * 16640), lane, (blk - 32) * NWAVES + wave, 224 * NWAVES, 22 + l, 23 + l); transpose_jobs(a, ws, (LAS float*)(lds + wave * 16640), lane, (blk - 32) * NWAVES + wave, 224 * NWAVES, 26 + l, 27 + l); } END(pb + 2); } }
            if (SEL(24) && PH(pb + 3)) { for (int rep_ = 0; rep_ < NREP(24); ++rep_) { LAUNDER
                if (blk < 16) { pg8::EpiFrag<false> E{(bf16*)(scr + SN_KCF)}; run_gemm(lds, (const bf16*)(scr + SN_HCK), 256, (const bf16*)(ws + WS_WC2) + (size_t)(li * 2 + 0) * 256 * 256, 256, 4096, 256, 256, E, 16, blk, tid); }
                else if (blk < 32) { pg8::EpiFrag<true> E{(bf16*)(scr + SN_VCF)}; run_gemm(lds, (const bf16*)(scr + SN_HCV), 256, (const bf16*)(ws + WS_WC2) + (size_t)(li * 2 + 1) * 256 * 256, 256, 4096, 256, 256, E, 16, blk - 16, tid); }
                END(pb + 3); } }
            for (int rp_ = 0; rp_ < REPPAIR; ++rp_) {
            if (SEL(25) && PH(pb + 4)) { for (int rep_ = 0; rep_ < NREP(25); ++rep_) { LAUNDER nsa_cmp(lds, tid, lane, wave, G, blk, scr, (bf16*)(scr + SN_YF), (unsigned long long*)(scr + SN_SELM)); END(pb + 4); } }
            if (SEL(26) && PH(pb + 5)) { for (int rep_ = 0; rep_ < NREP(26); ++rep_) { LAUNDER { if (rep_ + 1 < NREP(26)) nsa_selwin<DRYMODE>(lds, tid, lane, wave, G, blk, scr, (const bf16*)(scr + SN_YF), (bf16*)(scr + SN_YF + (size_t)MTOK * DM * 2)); else nsa_selwin<0>(lds, tid, lane, wave, G, blk, scr, (const bf16*)(scr + SN_YF), Y); } END(pb + 5); } }
            }
            if (SEL(28) && PH(pb + 7)) { for (int rep_ = 0; rep_ < NREP(28); ++rep_) { LAUNDER pg8::EpiBf16<0> E{MF, DM, nullptr}; run_gemm(lds, Y, DM, (const bf16*)(ws + WS_WNSA_OUT) + (size_t)li * DM * DM, DM, MTOK, DM, DM, E, G, blk, tid); END(pb + 7); } }
        }
        if (SEL(9) && PH(pb + 8)) { for (int rep_ = 0; rep_ < NREP(9); ++rep_) { LAUNDER rowpass(gw, ngw, lane, MF, l == 0 ? a.in[0] : nullptr, HB, nullptr, HB, nw + (size_t)(l * 4 + 1) * DM, nw + (size_t)(l * 4 + 2) * DM, XN); END(pb + 8); } }
        if (SEL(10) && PH(pb + 9)) { for (int rep_ = 0; rep_ < NREP(10); ++rep_) { LAUNDER pg8::EpiAct E{(bf16*)(scr + SC_ACT), a.in[18] + (size_t)l * 3 * DFF, (float*)(ws + WS_SG), (float*)(ws + WS_S0), (LAS float*)(lds + 131072), DFF}; run_gemm(lds, XN, DM, (const bf16*)(ws + WS_WGU) + (size_t)l * 2 * DFF * DM, DM, MTOK, 2 * DFF, DM, E, G, blk, tid); END(pb + 9); } }
        if (SEL(11) && PH(pb + 10)) { for (int rep_ = 0; rep_ < NREP(11); ++rep_) { LAUNDER ffn_fix(blk * NTHR + tid, G * NTHR, (const float*)(ws + WS_SG), (const float*)(ws + WS_S0), a.in[18] + (size_t)l * 3 * DFF, (bf16*)(scr + SC_ACT)); END(pb + 10); } }
        if (SEL(12) && PH(pb + 11)) { for (int rep_ = 0; rep_ < NREP(12); ++rep_) { LAUNDER pg8::EpiBf16<0> E{MF, DM, nullptr}; run_gemm(lds, (const bf16*)(scr + SC_ACT), DFF, (const bf16*)(ws + WS_WDN) + (size_t)l * DM * DFF, DFF, MTOK, DM, DFF, E, G, blk, tid); END(pb + 11); } }
        if (SEL(13) && PH(pb + 12)) { for (int rep_ = 0; rep_ < NREP(13); ++rep_) { LAUNDER rowpass(gw, ngw, lane, MF, nullptr, HB, l == 3 ? H : nullptr, HB, nw + (size_t)(l * 4 + 3) * DM, l < 3 ? nw + (size_t)((l + 1) * 4 + 0) * DM : nullptr, XN); END(pb + 12); } }
    }
#undef PH
#undef END
}

static bool phase_exists(int p) { if (p == 0) return true; const int l = (p - 1) / PH_PER_LAYER, k = (p - 1) % PH_PER_LAYER; if ((l & 1) == 0 && (k == 5 || k == 6 || k == 7)) return false; return true; }
extern "C" void kernel_launch(void* const* d_in, const int* in_sizes, int n_in, void* d_out, int out_size, void* d_ws, size_t ws_size, hipStream_t stream) {
    static int grid = 0;
    if (grid == 0) {
        if (n_in != 20 || out_size != MTOK * DM || ws_size < WS_END) { fprintf(stderr, "kernel_launch: unexpected shapes (n_in %d out %d ws %zu need %zu)\n", n_in, out_size, ws_size, (size_t)WS_END); grid = -1; return; }
        int dev = 0, cus = 0, per_cu = 0;
        if (hipGetDevice(&dev) != hipSuccess || hipDeviceGetAttribute(&cus, hipDeviceAttributeMultiprocessorCount, dev) != hipSuccess) { grid = -1; return; }
        if (hipFuncSetAttribute((const void*)fwd_kernel, hipFuncAttributeMaxDynamicSharedMemorySize, LDS_BYTES) != hipSuccess) { fprintf(stderr, "kernel_launch: hipFuncSetAttribute failed\n"); grid = -1; return; }
        if (hipOccupancyMaxActiveBlocksPerMultiprocessor(&per_cu, (const void*)fwd_kernel, NTHR, LDS_BYTES) != hipSuccess || per_cu < 1) { fprintf(stderr, "kernel_launch: occupancy query reports %d\n", per_cu); }
        (void)hipGetLastError();
        grid = cus;
    }
    if (grid < 0) return;
    (void)hipMemsetAsync((char*)d_ws + WS_CTL, 0, CTL_ZERO_BYTES, stream);
    Args a{};
    for (int i = 0; i < 20; ++i) a.in[i] = (const float*)d_in[i];
    a.out = (float*)d_out; a.ws = (unsigned char*)d_ws;
#if MK_MULTI
    for (int p = 0; p < NPHASE; ++p) { if (!phase_exists(p)) continue; a.ph_lo = p; a.ph_hi = p + 1; hipLaunchKernelGGL(fwd_kernel, dim3(grid), dim3(NTHR), LDS_BYTES, stream, a); }
#else
    a.ph_lo = 0; a.ph_hi = NPHASE; hipLaunchKernelGGL(fwd_kernel, dim3(grid), dim3(NTHR), LDS_BYTES, stream, a);
#endif
}
```

```cpp
#include <hip/hip_runtime.h>
#include <cstdio>
#include <cstdint>

#define GAS __attribute__((address_space(1)))
#define LAS __attribute__((address_space(3)))
#define DI __device__ __forceinline__
typedef unsigned short bf16;
typedef short bf16x8 __attribute__((ext_vector_type(8)));
typedef float f32x4 __attribute__((ext_vector_type(4)));
typedef float f32x2 __attribute__((ext_vector_type(2)));
typedef unsigned u32x4 __attribute__((ext_vector_type(4)));
typedef unsigned u32x2 __attribute__((ext_vector_type(2)));
typedef __bf16 bfv2 __attribute__((ext_vector_type(2)));

DI unsigned pk2(float a, float b) { f32x2 v = {a, b}; bfv2 r = __builtin_convertvector(v, bfv2); return __builtin_bit_cast(unsigned, r); }
DI bf16 f2bf(float a) { return (bf16)(pk2(a, 0.f) & 0xffffu); }
DI float bf2f(bf16 b) { return __uint_as_float(((unsigned)b) << 16); }
DI float bflo(unsigned w) { return __uint_as_float(w << 16); }
DI float bfhi(unsigned w) { return __uint_as_float(w & 0xffff0000u); }
DI float silu_f(float x) { return x * __builtin_amdgcn_rcpf(1.f + __expf(-x)); }
DI float sigmoid_f(float x) { return __builtin_amdgcn_rcpf(1.f + __expf(-x)); }
DI bf16x8 pack8(f32x4 a, f32x4 b) { u32x4 p; p.x = pk2(a.x, a.y); p.y = pk2(a.z, a.w); p.z = pk2(b.x, b.y); p.w = pk2(b.z, b.w); return __builtin_bit_cast(bf16x8, p); }
#define MFMA16(a, b, c) __builtin_amdgcn_mfma_f32_16x16x32_bf16((a), (b), (c), 0, 0, 0)
DI void lds_barrier() { asm volatile("s_waitcnt lgkmcnt(0)" ::: "memory"); __builtin_amdgcn_s_barrier(); asm volatile("" ::: "memory"); }
DI float wave_sum(float v) {
#pragma unroll
    for (int o = 1; o < 64; o <<= 1) v += __shfl_xor(v, o);
    return v;
}

DI float max2f(float a, float b) { float r; asm("v_max_f32 %0, %1, %2" : "=v"(r) : "v"(a), "v"(b)); return r; }
DI float max3f(float a, float b, float c) { float r; asm("v_max3_f32 %0, %1, %2, %3" : "=v"(r) : "v"(a), "v"(b), "v"(c)); return r; }
DI float max16f(const f32x4 (&s)[4]) {
    const float a = max3f(s[0][0], s[0][1], s[0][2]), b = max3f(s[0][3], s[1][0], s[1][1]), c = max3f(s[1][2], s[1][3], s[2][0]), d = max3f(s[2][1], s[2][2], s[2][3]), e = max3f(s[3][0], s[3][1], s[3][2]);
    return max3f(max3f(a, b, c), max3f(d, e, s[3][3]), s[3][3]);
}
typedef float f32x2 __attribute__((ext_vector_type(2)));
DI f32x2 sub_pk(f32x2 a, f32x2 b) { f32x2 r; asm("v_pk_add_f32 %0, %1, %2 neg_lo:[0,1] neg_hi:[0,1]" : "=v"(r) : "v"(a), "v"(b)); return r; }
DI void scale_inplace(f32x4& o, float al) {
    f32x2 lo = {o.x, o.y}, hi = {o.z, o.w}; const f32x2 a2 = {al, al};
    asm("v_pk_mul_f32 %0, %0, %1" : "+v"(lo) : "v"(a2)); asm("v_pk_mul_f32 %0, %0, %1" : "+v"(hi) : "v"(a2));
    o = (f32x4){lo.x, lo.y, hi.x, hi.y};
}
DI float quad_max(float v) {
    auto q = __builtin_amdgcn_permlane16_swap(__float_as_uint(v), __float_as_uint(v), false, false); v = max2f(__uint_as_float(q[0]), __uint_as_float(q[1]));
    auto r = __builtin_amdgcn_permlane32_swap(__float_as_uint(v), __float_as_uint(v), false, false); return max2f(__uint_as_float(r[0]), __uint_as_float(r[1])); }
DI float quad_sum(float v) {
    auto q = __builtin_amdgcn_permlane16_swap(__float_as_uint(v), __float_as_uint(v), false, false); v = __uint_as_float(q[0]) + __uint_as_float(q[1]);
    auto r = __builtin_amdgcn_permlane32_swap(__float_as_uint(v), __float_as_uint(v), false, false); return __uint_as_float(r[0]) + __uint_as_float(r[1]); }

namespace pg8 {
#define PG8_LAS __attribute__((address_space(3)))
typedef unsigned short bf16_t;
constexpr int BM = 256, BK = 64, HALF = 128, HTB = HALF * BK * 2, STAGE_BYTES = 8 * HTB, NXCD = 8, WGM = 8;
__host__ __device__ __forceinline__ int lds_byte(int r, int c) { const int st = (r >> 4) * 2 + (c >> 5), rr = r & 15, cc = c & 31, ob = rr * 64 + cc * 2; return st * 1024 + (ob ^ (((ob >> 9) & 1) << 5)); }
__host__ __device__ __forceinline__ void stage_rc(int b, int& R, int& C) { const int st = b / 1024, sb = b % 1024, swz = sb ^ (((sb >> 9) & 1) << 5); R = (st >> 1) * 16 + swz / 64; C = (st & 1) * 32 + (swz % 64) / 2; }
__host__ __device__ __forceinline__ int perm32(int rho) { const int n = rho >> 4, i = rho & 15; return 8 * (i >> 2) + 4 * n + (i & 3); }
struct Unit { int pm, pn; };
struct Gemm { const bf16_t* A; const bf16_t* Bt; int M, N, K, lda, ldb; };
struct StaticOrder {
    int nM, nN, nwg, G, c;
    __host__ __device__ void init(int M, int N, int G_, int c_) { nM = M / BM; nN = N / BM; nwg = nM * nN; G = G_; c = c_; }
    __host__ __device__ bool next(int i, Unit& u) const {
        const long L = (long)i * G + c; if (L >= nwg || c < 0) return false;
        int wgid = (int)L; { const int q = nwg / NXCD, r = nwg % NXCD, xcd = wgid % NXCD, off = wgid / NXCD; wgid = (xcd < r ? xcd * (q + 1) : r * (q + 1) + (xcd - r) * q) + off; }
        const int nig = WGM * nN, gid = wgid / nig, fm = gid * WGM, gsz = (nM - fm) < WGM ? (nM - fm) : WGM;
        u.pm = fm + ((wgid % nig) % gsz); u.pn = (wgid % nig) / gsz; return true;
    }
    __device__ __forceinline__ void a_ready(const Unit&) const {}
    __device__ __forceinline__ void done(const Unit&) const {}
};
__device__ __forceinline__ float gelu_tanh(float x) { const float y = 0.7978845608028654f * (x + 0.044715f * x * x * x); const float e = __expf(2.f * y); const float th = 1.f - 2.f / (e + 1.f); return 0.5f * x * (1.f + th); }
template <int ACT> struct EpiBf16 {
    static constexpr bool PERM = true, AFTER_DRAIN = false;
    bf16_t* O; int ldc; const float* bias; const float* rs;
    __device__ __forceinline__ void operator()(const f32x4 (&acc)[2][2][4][2], const Unit& u, int wr, int wc, int fr, int fq) const {
        const int row0 = u.pm * BM + wr * 64 + fr; const int col0 = u.pn * BM + wc * 32 + 8 * fq;
        f32x4 bv[2][2];
#pragma unroll
        for (int bj = 0; bj < 2; ++bj)
#pragma unroll
            for (int n = 0; n < 2; ++n) bv[bj][n] = bias ? *(const f32x4*)(bias + col0 + bj * HALF + 4 * n) : (f32x4){0.f, 0.f, 0.f, 0.f};
#pragma unroll
        for (int ai = 0; ai < 2; ++ai)
#pragma unroll
            for (int m = 0; m < 4; ++m) { bf16_t* rowp = O + (size_t)(row0 + ai * HALF + m * 16) * ldc + col0; const float sc = rs ? rs[row0 + ai * HALF + m * 16] : 1.f;
#pragma unroll
                for (int bj = 0; bj < 2; ++bj) { f32x4 v0 = acc[ai][bj][m][0] * sc + bv[bj][0], v1 = acc[ai][bj][m][1] * sc + bv[bj][1];
                    if (ACT == 1) {
#pragma unroll
                        for (int j = 0; j < 4; ++j) { v0[j] = gelu_tanh(v0[j]); v1[j] = gelu_tanh(v1[j]); } }
                    u32x4 w; w.x = pk2(v0[0], v0[1]); w.y = pk2(v0[2], v0[3]); w.z = pk2(v1[0], v1[1]); w.w = pk2(v1[2], v1[3]);
                    *(u32x4*)(rowp + bj * HALF) = w; } }
    }
};
struct EpiF32 {
    static constexpr bool PERM = false, AFTER_DRAIN = false;
    float* C; int ldc;
    __device__ __forceinline__ void operator()(const f32x4 (&acc)[2][2][4][2], const Unit& u, int wr, int wc, int fr, int fq) const {
        const int row0 = u.pm * BM + wr * 64 + fr, col0 = u.pn * BM + wc * 32 + 4 * fq;
#pragma unroll
        for (int ai = 0; ai < 2; ++ai)
#pragma unroll
            for (int m = 0; m < 4; ++m) { float* rowp = C + (size_t)(row0 + ai * HALF + m * 16) * ldc + col0;
#pragma unroll
                for (int bj = 0; bj < 2; ++bj)
#pragma unroll
                    for (int n = 0; n < 2; ++n) *(f32x4*)(rowp + bj * HALF + n * 16) = acc[ai][bj][m][n]; }
    }
};
template <bool ISV> struct EpiFrag {
    static constexpr bool PERM = false, AFTER_DRAIN = false;
    bf16_t* O;
    __device__ __forceinline__ void operator()(const f32x4 (&acc)[2][2][4][2], const Unit& u, int wr, int wc, int fr, int fq) const {
        bf16_t* base = O + (size_t)u.pm * 32768;
#pragma unroll
        for (int ai = 0; ai < 2; ++ai)
#pragma unroll
            for (int m = 0; m < 4; ++m) { const int c = ai * HALF + wr * 64 + m * 16 + fr;
#pragma unroll
                for (int n = 0; n < 2; ++n) { const int d = wc * 32 + 16 * n + 4 * fq; const f32x4 v = acc[ai][0][m][n];
                    if (!ISV) { const int off = (c >> 6) * 8192 + ((((c >> 4) & 3) * 4 + (d >> 5)) * 64 + ((d >> 3) & 3) * 16 + (c & 15)) * 8 + (d & 7);
                        u32x2 w; w.x = pk2(v[0], v[1]); w.y = pk2(v[2], v[3]); *(u32x2*)(base + off) = w; }
                    else { const int ck = c & 63, off = (c >> 6) * 8192 + (((d >> 4) * 2 + (ck >> 5)) * 64 + ((ck >> 2) & 3) * 16 + (d & 15)) * 8 + ((ck >> 4) & 1) * 4 + (ck & 3);
#pragma unroll
                        for (int j = 0; j < 4; ++j) base[off + 8 * j] = f2bf(v[j]); } } }
    }
};

__device__ __forceinline__ float dpp_ror1(float v) { return __int_as_float(__builtin_amdgcn_update_dpp(0, __float_as_int(v), 0x121, 0xF, 0xF, false)); }
__device__ __forceinline__ float dpp_ror2(float v) { return __int_as_float(__builtin_amdgcn_update_dpp(0, __float_as_int(v), 0x122, 0xF, 0xF, false)); }
__device__ __forceinline__ float silu_fast(float x) { return x * __builtin_amdgcn_rcpf(1.f + __expf(-x)); }
struct EpiAct {
    static constexpr bool PERM = true, AFTER_DRAIN = false;
    bf16_t* ACT; const float* cw; float* SG; float* S0; PG8_LAS float* X; int dff; const float* rs;
    __device__ __forceinline__ void operator()(const f32x4 (&acc)[2][2][4][2], const Unit& u, int wr, int wc, int fr, int fq) const {
        const int ch0 = u.pn * 128 + wc * 32 + 8 * fq;
        f32x4 wv[2][3];
#pragma unroll
        for (int n = 0; n < 2; ++n)
#pragma unroll
            for (int k = 0; k < 3; ++k) wv[n][k] = *(const f32x4*)(cw + (size_t)k * dff + ch0 + 4 * n);
        float sc[2][4];
#pragma unroll
        for (int ai = 0; ai < 2; ++ai)
#pragma unroll
            for (int m = 0; m < 4; ++m) sc[ai][m] = rs[u.pm * BM + ai * HALF + wr * 64 + m * 16 + fr];
        if (fr >= 14) {
#pragma unroll
            for (int ai = 0; ai < 2; ++ai) { PG8_LAS float* xp = X + ((wc * 4 + 2 * ai + wr) * 64 + fq * 8) * 2 + (fr - 14);
#pragma unroll
                for (int n = 0; n < 2; ++n)
#pragma unroll
                    for (int j = 0; j < 4; ++j) xp[(n * 4 + j) * 2] = acc[ai][0][3][n][j] * sc[ai][3]; }
        }
        asm volatile("s_waitcnt lgkmcnt(0)" ::: "memory"); __builtin_amdgcn_s_barrier(); asm volatile("" ::: "memory");
#pragma unroll
        for (int n = 0; n < 2; ++n) {
            f32x4 w[3];
#pragma unroll
            for (int k = 0; k < 3; ++k) w[k] = wv[n][k];
#pragma unroll
            for (int ai = 0; ai < 2; ++ai) {
                const int strip = 2 * ai + wr;
                f32x4 h1 = {0.f, 0.f, 0.f, 0.f}, h2 = {0.f, 0.f, 0.f, 0.f};
                if (strip > 0) { const PG8_LAS f32x2* xp = (const PG8_LAS f32x2*)(X + ((wc * 4 + strip - 1) * 64 + fq * 8 + n * 4) * 2);
#pragma unroll
                    for (int j = 0; j < 4; ++j) { const f32x2 q = xp[j]; h2[j] = q.x; h1[j] = q.y; } }
                f32x4 pr1 = h1, pr2 = (fr == 0) ? h2 : h1;
#pragma unroll
                for (int m = 0; m < 4; ++m) {
                    const f32x4 g = acc[ai][0][m][n] * sc[ai][m], up = acc[ai][1][m][n] * sc[ai][m];
                    f32x4 r1, r2, a;
#pragma unroll
                    for (int j = 0; j < 4; ++j) { r1[j] = dpp_ror1(g[j]); r2[j] = dpp_ror2(g[j]); }
#pragma unroll
                    for (int j = 0; j < 4; ++j) { const float p1 = fr >= 1 ? r1[j] : pr1[j], p2 = fr >= 2 ? r2[j] : pr2[j];
                        a[j] = silu_fast(w[0][j] * p2 + w[1][j] * p1 + w[2][j] * g[j]) * up[j]; }
                    pr1 = r1; pr2 = r2;
                    u32x2 o; o.x = pk2(a[0], a[1]); o.y = pk2(a[2], a[3]);
                    *(u32x2*)(ACT + (size_t)(u.pm * BM + ai * HALF + wr * 64 + m * 16 + fr) * dff + ch0 + 4 * n) = o;
                }
            }
        }
        if (wr == 1 && fr >= 14) { float* p = SG + ((size_t)u.pm * 2 + (fr - 14)) * dff + ch0; *(f32x4*)p = acc[1][0][3][0] * sc[1][3]; *(f32x4*)(p + 4) = acc[1][0][3][1] * sc[1][3]; }
        if (wr == 0 && fr < 2) { float* p = S0 + (((size_t)u.pm * 2 + fr) * 2) * dff + ch0; *(f32x4*)p = acc[0][0][0][0] * sc[0][0]; *(f32x4*)(p + 4) = acc[0][0][0][1] * sc[0][0]; *(f32x4*)(p + dff) = acc[0][1][0][0] * sc[0][0]; *(f32x4*)(p + dff + 4) = acc[0][1][0][1] * sc[0][0]; }
    }
};
template <class Epi, class Sched, bool ALIGN_EPI = false, bool SP2 = false>
__device__ __forceinline__ void gemm_phase(PG8_LAS unsigned char* lds, const Gemm g, const Sched& S, const Epi& E, const int tid) {
    const int wid = __builtin_amdgcn_readfirstlane(tid >> 6), lane = tid & 63, wr = wid >> 2, wc = wid & 3, fr = lane & 15, fq = lane >> 4;
    const int K = g.K, nt = K / BK;
    unsigned voffA[2], voffB[2];
#pragma unroll
    for (int i = 0; i < 2; ++i) { int R, C; stage_rc(tid * 16 + i * 8192, R, C); const int Rb = Epi::PERM ? ((R & ~31) + perm32(R & 31)) : R;
        voffA[i] = (unsigned)(R * g.lda + C) * 2u; voffB[i] = (unsigned)(Rb * g.ldb + C) * 2u; }
    const size_t kstep = (size_t)(BK * 2);
    const size_t hstepA = (size_t)HALF * g.lda * 2, hstepB = (size_t)HALF * g.ldb * 2;
    const size_t tstepA = 2 * hstepA, tstepB = 2 * hstepB;
    const unsigned ldsw = (unsigned)wid * 1024u;
    const int aoff = lds_byte(wr * 64 + fr, fq * 8), boff = lds_byte(wc * 32 + fr, fq * 8);
#define PG8_SA(b, h) (((b) * 2 + (h)) * HTB)
#define PG8_SB(b, h) ((4 + (b) * 2 + (h)) * HTB)
#define PG8_STAGE(bufoff, gbase, voff) do { _Pragma("unroll") for (int _i = 0; _i < 2; ++_i) \
        __builtin_amdgcn_global_load_lds((const unsigned*)((const char*)(gbase) + (voff)[_i]), (PG8_LAS unsigned*)(lds + (bufoff) + ldsw + _i * 8192), 16, 0, 0); } while (0)
#define PG8_LDA(dst, b, h) do { _Pragma("unroll") for (int m = 0; m < 4; ++m) _Pragma("unroll") for (int k = 0; k < 2; ++k) dst[m][k] = *(const PG8_LAS bf16x8*)(lds + PG8_SA(b, h) + aoff + m * 2048 + k * 1024); } while (0)
#define PG8_LDB(dst, b, h) do { _Pragma("unroll") for (int n = 0; n < 2; ++n) _Pragma("unroll") for (int k = 0; k < 2; ++k) dst[n][k] = *(const PG8_LAS bf16x8*)(lds + PG8_SB(b, h) + boff + n * 2048 + k * 1024); } while (0)
#define PG8_MMA(ai, bj, At, Bt) do { __builtin_amdgcn_s_setprio(1); _Pragma("unroll") for (int m = 0; m < 4; ++m) _Pragma("unroll") for (int n = 0; n < 2; ++n) _Pragma("unroll") for (int k = 0; k < 2; ++k) \
        acc[ai][bj][m][n] = __builtin_amdgcn_mfma_f32_16x16x32_bf16(Bt[n][k], At[m][k], acc[ai][bj][m][n], 0, 0, 0); __builtin_amdgcn_s_setprio(0); } while (0)
#define PG8_WAIT_V(n) asm volatile("s_waitcnt vmcnt(" #n ")" ::: "memory")
#define PG8_WAIT_L(n) asm volatile("s_waitcnt lgkmcnt(" #n ")" ::: "memory")
#define PG8_BAR __builtin_amdgcn_s_barrier()
#define PG8_SCHED __builtin_amdgcn_sched_barrier(0)
    Unit cur, nxt; int ui = 0;
    if (!S.next(0, cur)) return;
    f32x4 acc[2][2][4][2];
#pragma unroll
    for (int a = 0; a < 2; ++a)
#pragma unroll
        for (int b = 0; b < 2; ++b)
#pragma unroll
            for (int m = 0; m < 4; ++m)
#pragma unroll
                for (int n = 0; n < 2; ++n) acc[a][b][m][n] = (f32x4){0.f, 0.f, 0.f, 0.f};
    bf16x8 At[4][2], B0[2][2], B1[2][2];
    const char* cA = (const char*)g.A + (size_t)cur.pm * tstepA; const char* cB = (const char*)g.Bt + (size_t)cur.pn * tstepB;
    S.a_ready(cur);
    if constexpr (SP2) {
        PG8_STAGE(PG8_SB(0, 0), cB, voffB); PG8_STAGE(PG8_SB(0, 1), cB + hstepB, voffB); PG8_STAGE(PG8_SA(0, 0), cA, voffA); PG8_STAGE(PG8_SA(0, 1), cA + hstepA, voffA);
        if (wr == 1) PG8_BAR;
        PG8_WAIT_V(2); PG8_BAR;
        PG8_STAGE(PG8_SB(1, 0), cB + kstep, voffB); PG8_STAGE(PG8_SA(1, 0), cA + kstep, voffA); PG8_STAGE(PG8_SB(1, 1), cB + hstepB + kstep, voffB);
        PG8_WAIT_V(6); PG8_BAR;
    } else {
        PG8_STAGE(PG8_SB(0, 0), cB, voffB); PG8_STAGE(PG8_SA(0, 0), cA, voffA); PG8_STAGE(PG8_SB(0, 1), cB + hstepB, voffB); PG8_STAGE(PG8_SA(0, 1), cA + hstepA, voffA);
        if (wr == 1) PG8_BAR;
        PG8_WAIT_V(4); PG8_BAR;
        PG8_STAGE(PG8_SB(1, 0), cB + kstep, voffB); PG8_STAGE(PG8_SA(1, 0), cA + kstep, voffA); PG8_STAGE(PG8_SB(1, 1), cB + hstepB + kstep, voffB);
        PG8_WAIT_V(6); PG8_BAR;
    }
    for (;;) {
        const bool has_next = S.next(ui + 1, nxt);
        const char* nA = has_next ? (const char*)g.A + (size_t)nxt.pm * tstepA : cA; const char* nB = has_next ? (const char*)g.Bt + (size_t)nxt.pn * tstepB : cB;
        for (int t = 0; t < nt; t += 2) {
            const bool last = (t == nt - 2);
            const char* a1 = cA + (size_t)(t + 1) * kstep;
            const char* a2 = last ? nA : cA + (size_t)(t + 2) * kstep; const char* b2 = last ? nB : cB + (size_t)(t + 2) * kstep;
            const char* a3 = a2 + kstep; const char* b3 = b2 + kstep;
            if (last && has_next) S.a_ready(nxt);
            if constexpr (SP2) {
            PG8_LDB(B0, 0, 0); PG8_LDB(B1, 0, 1); PG8_SCHED; PG8_LDA(At, 0, 0); PG8_STAGE(PG8_SA(1, 1), a1 + hstepA, voffA);
            PG8_WAIT_V(8); PG8_WAIT_L(0); PG8_BAR; PG8_MMA(0, 0, At, B0); PG8_MMA(0, 1, At, B1); PG8_BAR; PG8_SCHED;
            PG8_LDA(At, 0, 1); PG8_STAGE(PG8_SB(0, 0), b2, voffB); PG8_STAGE(PG8_SB(0, 1), b2 + hstepB, voffB); PG8_STAGE(PG8_SA(0, 0), a2, voffA);
            PG8_WAIT_V(8); PG8_WAIT_L(0); PG8_BAR; PG8_MMA(1, 0, At, B0); PG8_MMA(1, 1, At, B1); PG8_BAR; PG8_SCHED;
            PG8_LDB(B0, 1, 0); PG8_LDB(B1, 1, 1); PG8_SCHED; PG8_LDA(At, 1, 0); PG8_STAGE(PG8_SA(0, 1), a2 + hstepA, voffA);
            PG8_WAIT_V(8); PG8_WAIT_L(0); PG8_BAR; PG8_MMA(0, 0, At, B0); PG8_MMA(0, 1, At, B1); PG8_BAR; PG8_SCHED;
            PG8_LDA(At, 1, 1); PG8_STAGE(PG8_SB(1, 0), b3, voffB); PG8_STAGE(PG8_SB(1, 1), b3 + hstepB, voffB); PG8_STAGE(PG8_SA(1, 0), a3, voffA);
            PG8_WAIT_V(8); PG8_WAIT_L(0); PG8_BAR; PG8_MMA(1, 0, At, B0); PG8_MMA(1, 1, At, B1); PG8_BAR; PG8_SCHED;
            } else {
            PG8_LDB(B0, 0, 0); PG8_SCHED; PG8_LDA(At, 0, 0); PG8_STAGE(PG8_SA(1, 1), a1 + hstepA, voffA);
            PG8_WAIT_L(8); PG8_BAR; PG8_WAIT_L(0); PG8_MMA(0, 0, At, B0); PG8_BAR; PG8_SCHED;
            PG8_LDB(B1, 0, 1); PG8_STAGE(PG8_SB(0, 0), b2, voffB);
            PG8_BAR; PG8_WAIT_L(0); PG8_MMA(0, 1, At, B1); PG8_BAR;
            PG8_LDA(At, 0, 1); PG8_STAGE(PG8_SA(0, 0), a2, voffA);
            PG8_BAR; PG8_WAIT_L(0); PG8_MMA(1, 0, At, B0); PG8_BAR; PG8_SCHED;
            PG8_STAGE(PG8_SB(0, 1), b2 + hstepB, voffB);
            PG8_WAIT_V(6); PG8_BAR; PG8_MMA(1, 1, At, B1); PG8_BAR;
            PG8_LDB(B0, 1, 0); PG8_SCHED; PG8_LDA(At, 1, 0); PG8_STAGE(PG8_SA(0, 1), a2 + hstepA, voffA);
            PG8_WAIT_L(8); PG8_BAR; PG8_WAIT_L(0); PG8_MMA(0, 0, At, B0); PG8_BAR; PG8_SCHED;
            PG8_LDB(B1, 1, 1); PG8_STAGE(PG8_SB(1, 0), b3, voffB);
            PG8_BAR; PG8_WAIT_L(0); PG8_MMA(0, 1, At, B1); PG8_BAR;
            PG8_LDA(At, 1, 1); PG8_STAGE(PG8_SA(1, 0), a3, voffA);
            PG8_BAR; PG8_WAIT_L(0); PG8_MMA(1, 0, At, B0); PG8_BAR; PG8_SCHED;
            PG8_STAGE(PG8_SB(1, 1), b3 + hstepB, voffB);
            PG8_WAIT_V(6); PG8_BAR; PG8_MMA(1, 1, At, B1); PG8_BAR;
            }
        }
        if constexpr (ALIGN_EPI) { if (wr == 0) PG8_BAR; }
        if constexpr (!Epi::AFTER_DRAIN) { E(acc, cur, wr, wc, fr, fq); S.done(cur); }
        if (!has_next) break;
#pragma unroll
        for (int a = 0; a < 2; ++a)
#pragma unroll
            for (int b = 0; b < 2; ++b)
#pragma unroll
                for (int m = 0; m < 4; ++m)
#pragma unroll
                    for (int n = 0; n < 2; ++n) acc[a][b][m][n] = (f32x4){0.f, 0.f, 0.f, 0.f};
        cur = nxt; cA = nA; cB = nB; ++ui;
        if constexpr (ALIGN_EPI) { if (wr == 1) PG8_BAR; }
    }
    PG8_WAIT_V(0);
    if constexpr (!ALIGN_EPI) { if (wr == 0) PG8_BAR; }
    PG8_BAR;
    if constexpr (Epi::AFTER_DRAIN) { E.fused(acc, cur, wr, wc, fr, fq, lds, wid, lane); S.done(cur); }
#undef PG8_SA
#undef PG8_SB
#undef PG8_STAGE
#undef PG8_LDA
#undef PG8_LDB
#undef PG8_MMA
#undef PG8_WAIT_V
#undef PG8_WAIT_L
#undef PG8_BAR
#undef PG8_SCHED
}
}

#define XB_TMO      128
#define XB_XCNT(j)  (256  + 64 * (j))
#define XB_XSUB(j)  (1280 + 64 * (j))
#define XB_XGEN(j)  (2304 + 64 * (j))
#define XB_TOP      3328
#define XB_TOPGEN   3392
#define XCD_BAR_WORDS 3456
#define XB_SPIN_CAP (1u << 22)
__device__ __forceinline__ unsigned xb_ld(unsigned* p)              { return __hip_atomic_load(p, __ATOMIC_RELAXED, __HIP_MEMORY_SCOPE_AGENT); }
__device__ __forceinline__ unsigned xb_add(unsigned* p, unsigned v) { return __hip_atomic_fetch_add(p, v, __ATOMIC_RELAXED, __HIP_MEMORY_SCOPE_AGENT); }
__device__ __forceinline__ unsigned xb_xcc_id() { return (unsigned)__builtin_amdgcn_s_getreg((3 << 11) | 20) & 0xFu; }
#define XB_SPIN(cond, bar) do { unsigned _sp = 0; while (cond) { __builtin_amdgcn_s_sleep(1); \
    if ((++_sp & 255u) == 0u) { if (xb_ld(&(bar)[XB_TMO])) break; if (_sp > XB_SPIN_CAP) { atomicAdd(&(bar)[XB_TMO], 1u); break; } } } } while (0)
struct XcdBarrier { unsigned* bar; unsigned x; volatile LAS unsigned* st; };
__device__ __forceinline__ XcdBarrier xcd_barrier_post(unsigned* bar, volatile LAS unsigned* st) {
    XcdBarrier b; b.bar = bar; b.x = xb_xcc_id(); b.st = st;
    if (threadIdx.x == 0) (void)xb_add(&bar[XB_XCNT(b.x)], 1u);
    return b;
}
__device__ __forceinline__ void xcd_barrier_complete(unsigned* bar, unsigned x, unsigned& nloc, unsigned& nx) {
    const unsigned G = gridDim.x * gridDim.y * gridDim.z;
    unsigned sum, cnt, mine, sp = 0u;
    for (;;) {
        sum = 0u; cnt = 0u; mine = 0u;
#pragma unroll
        for (unsigned j = 0; j < 16; ++j) { const unsigned c = xb_ld(&bar[XB_XCNT(j)]); sum += c; cnt += (c > 0u) ? 1u : 0u; mine = (j == x) ? c : mine; }
        if (sum == G) break;
        __builtin_amdgcn_s_sleep(1);
        if ((++sp & 255u) == 0u) { if (xb_ld(&bar[XB_TMO])) break; if (sp > XB_SPIN_CAP) { atomicAdd(&bar[XB_TMO], 1u); break; } }
    }
    nloc = mine > 0u ? mine : 1u; nx = cnt > 0u ? cnt : 1u;
}
__device__ __forceinline__ void xcd_barrier(const XcdBarrier& b) {
    asm volatile("s_waitcnt vmcnt(0)" ::: "memory");
    __syncthreads();
    if (threadIdx.x == 0) {
        unsigned* bar = b.bar; unsigned bx = b.x; asm volatile("" : "+s"(bar), "+s"(bx));
        __builtin_amdgcn_s_waitcnt(0);
        unsigned nloc = b.st[0], nx = b.st[1];
        const unsigned old = xb_add(&bar[XB_XSUB(bx)], 1u);
        const unsigned gen = old / nloc;
        if (old + 1u == (gen + 1u) * nloc) {
            __builtin_amdgcn_fence(__ATOMIC_RELEASE, "agent");
            asm volatile("s_waitcnt vmcnt(0)" ::: "memory");
            const unsigned og = xb_add(&bar[XB_TOP], 1u);
            const unsigned tg = og / nx;
            if (og + 1u == (tg + 1u) * nx) xb_add(&bar[XB_TOPGEN], 1u);
            else XB_SPIN(xb_ld(&bar[XB_TOPGEN]) == tg, bar);
            __builtin_amdgcn_fence(__ATOMIC_ACQUIRE, "agent");
            xb_add(&bar[XB_XGEN(bx)], 1u);
            asm volatile("s_waitcnt vmcnt(0)" ::: "memory");
        } else {
            XB_SPIN(xb_ld(&bar[XB_XGEN(bx)]) == gen, bar);
            __builtin_amdgcn_fence(__ATOMIC_ACQUIRE, "agent");
            asm volatile("s_waitcnt vmcnt(0)" ::: "memory");
        }
    }
    __syncthreads();
}

constexpr int NB = 4, SEQ = 4096, MTOK = NB * SEQ, DM = 2048, DFF = 5632;
constexpr int N_AB = 7168, N_NSA = 5120;
constexpr int LDP_AB = N_AB + 64, LDP_NSA = N_NSA + 64;
constexpr int NWAVES = 8, NTHR = 512;
constexpr float EPS = 1e-6f;
constexpr float NEGF = -1e30f;

constexpr size_t MiB = 1u << 20;
constexpr size_t WS_CTL = 0;
constexpr size_t CTL_ZERO_BYTES = 1 * MiB;
constexpr size_t WS_WAB_IN  = 1 * MiB;
constexpr size_t WS_WAB_OUT = WS_WAB_IN + (size_t)2 * N_AB * DM * 2;
constexpr size_t WS_WNSA_IN = WS_WAB_OUT + (size_t)2 * DM * DM * 2;
constexpr size_t WS_WNSA_OUT = WS_WNSA_IN + (size_t)2 * N_NSA * DM * 2;
constexpr size_t WS_WAB_S = WS_WNSA_OUT + (size_t)2 * DM * DM * 2;
constexpr size_t WS_WNSA_S = WS_WAB_S + (size_t)2 * 16 * DM * 2;
constexpr size_t WS_WC1 = WS_WNSA_S + (size_t)2 * 48 * DM * 2;
constexpr size_t WS_WC2 = WS_WC1 + (size_t)4 * 256 * 4096 * 2;
constexpr size_t WS_WGU = WS_WC2 + (size_t)4 * 256 * 256 * 2;
constexpr size_t WS_WDN = WS_WGU + (size_t)4 * 2 * DFF * DM * 2;
constexpr size_t WS_CBIAS = WS_WDN + (size_t)4 * DM * DFF * 2;
constexpr size_t WS_ROPE = WS_CBIAS + 4096;
constexpr size_t WS_SG = WS_ROPE + (size_t)2 * SEQ * 64 * 4;
constexpr size_t WS_S0 = WS_SG + (size_t)64 * 2 * DFF * 4;
constexpr size_t WS_SMALL = WS_S0 + (size_t)64 * 4 * DFF * 4;
constexpr size_t WS_XN = WS_SMALL + (size_t)MTOK * 48 * 4;
constexpr size_t WS_MF = WS_XN + (size_t)MTOK * DM * 2;
constexpr size_t WS_SCR = WS_MF + (size_t)MTOK * DM * 4;
constexpr size_t SC_PROJ = 0;
constexpr size_t SC_ACT  = (size_t)MTOK * 2 * DFF * 2;
constexpr size_t SC_GOPS = (size_t)MTOK * LDP_AB * 2;
constexpr size_t GOP_BYTES = 90112;
constexpr size_t SC_GEG  = SC_GOPS + (size_t)2048 * GOP_BYTES;
constexpr size_t SC_GO   = SC_GEG + 8192;
constexpr size_t SC_Y    = SC_GO + (size_t)MTOK * 1024 * 4;
constexpr size_t SN_QR   = (size_t)MTOK * LDP_NSA * 2;
constexpr size_t SN_KC   = SN_QR + (size_t)MTOK * DM * 2;
constexpr size_t SN_VC   = SN_KC + (size_t)16 * SEQ * 128 * 2;
constexpr size_t SN_KS   = SN_VC + (size_t)16 * SEQ * 128 * 2 + 8192;
constexpr size_t SN_VS   = SN_KS + (size_t)16 * SEQ * 128 * 2;
constexpr size_t SN_KW   = SN_VS + (size_t)16 * SEQ * 128 * 2;
constexpr size_t SN_VW   = SN_KW + (size_t)16 * SEQ * 128 * 2;
constexpr size_t SN_GATE = SN_VW + (size_t)16 * SEQ * 128 * 2;
constexpr size_t SN_HCK  = SN_GATE + (size_t)MTOK * 48 * 4;
constexpr size_t SN_HCV  = SN_HCK + (size_t)4096 * 256 * 2;
constexpr size_t SN_KCF  = SN_HCV + (size_t)4096 * 256 * 2;
constexpr size_t SN_VCF  = SN_KCF + (size_t)16 * 32768 * 2;
constexpr size_t SN_SELM = SN_VCF + (size_t)16 * 32768 * 2;
constexpr size_t SN_YF   = SN_SELM + (size_t)16 * SEQ * 8;
constexpr size_t SN_END  = SN_YF + (size_t)MTOK * DM * 4;
static_assert(SN_END <= SC_Y, "odd-layer scratch must stay below Y");
constexpr size_t SCR_BYTES = SC_Y + (size_t)MTOK * DM * 2;
static_assert(SC_ACT + (size_t)MTOK * DFF * 2 <= SCR_BYTES, "ACT fits");
constexpr size_t WS_END = WS_SCR + SCR_BYTES;
constexpr size_t WS_RS = WS_CTL + 512 * 1024;
constexpr int CW_BAR = 4096;

constexpr int LDS_BYTES = 155648;
constexpr int LDS_MISC = 155648 - 256;

struct Args { const float* in[20]; float* out; unsigned char* ws; int ph_lo, ph_hi; };

DI int map_col(int mode, int n, int c0, int drow0) { if (mode == 2) { const int isup = n >= DFF ? 1 : 0, ch = n - isup * DFF; return (ch >> 7) * 256 + isup * 128 + (ch & 127); } return drow0 + (n - c0); }
struct TJob { const float* W; int K, ldn, c0, nc; bf16* WT; int mode, drow0; const float* nk; };
DI void transpose_load(const TJob& J, int item, int lane, f32x4 (&v)[16]) {
    const int nblk = (J.nc + 63) / 64, kb = item / nblk, nb = item % nblk, k0 = 64 * kb, n0 = J.c0 + 64 * nb;
    const int nn = n0 + 4 * (lane & 15), kr = lane >> 4;
#pragma unroll
    for (int i = 0; i < 16; ++i) { v[i] = nn < J.c0 + J.nc ? *(const f32x4*)(J.W + (size_t)(k0 + kr + 4 * i) * J.ldn + nn) : (f32x4){0.f, 0.f, 0.f, 0.f}; if (J.nk) v[i] = v[i] * J.nk[k0 + kr + 4 * i]; }
}
DI void transpose_store(const TJob& J, int item, int lane, const f32x4 (&v)[16], LAS float* scr) {
    const int nblk = (J.nc + 63) / 64, kb = item / nblk, nb = item % nblk, k0 = 64 * kb, n0 = J.c0 + 64 * nb, kr = lane >> 4;
#pragma unroll
    for (int i = 0; i < 16; ++i) { LAS float* d = scr + (kr + 4 * i) * 65 + 4 * (lane & 15); d[0] = v[i].x; d[1] = v[i].y; d[2] = v[i].z; d[3] = v[i].w; }
    asm volatile("s_waitcnt lgkmcnt(0)" ::: "memory");
    const int c = lane & 7;
#pragma unroll
    for (int j = 0; j < 8; ++j) { const int nl = (lane >> 3) + 8 * j; const LAS float* s = scr + (8 * c) * 65 + nl;
        u32x4 o; o.x = pk2(s[0 * 65], s[1 * 65]); o.y = pk2(s[2 * 65], s[3 * 65]); o.z = pk2(s[4 * 65], s[5 * 65]); o.w = pk2(s[6 * 65], s[7 * 65]);
        if (n0 + nl < J.c0 + J.nc) *(u32x4*)(J.WT + (size_t)map_col(J.mode, n0 + nl, J.c0, J.drow0) * J.K + k0 + 8 * c) = o; }
    asm volatile("s_waitcnt lgkmcnt(0)" ::: "memory");
}
DI void zero_fill16(void* p, size_t bytes, size_t gtid, size_t gthreads) { u32x4* q = (u32x4*)p; const u32x4 z = {0u, 0u, 0u, 0u}; for (size_t i = gtid; i < bytes / 16; i += gthreads) q[i] = z; }

DI void load_row(const float* p, int lane, f32x4 (&v)[8]) {
#pragma unroll
    for (int j = 0; j < 8; ++j) v[j] = ((const f32x4*)p)[lane + 64 * j];
}
DI float row_ss(const f32x4 (&v)[8]) { float s = 0.f;
#pragma unroll
    for (int j = 0; j < 8; ++j) s += (v[j].x * v[j].x + v[j].y * v[j].y) + (v[j].z * v[j].z + v[j].w * v[j].w);
    return wave_sum(s); }
DI void store_row_bf16_normed(bf16* o, int lane, const f32x4 (&v)[8], float r, const float* w) {
#pragma unroll
    for (int j = 0; j < 8; ++j) { const f32x4 ww = ((const f32x4*)w)[lane + 64 * j]; u32x2 q; q.x = pk2(v[j].x * r * ww.x, v[j].y * r * ww.y); q.y = pk2(v[j].z * r * ww.z, v[j].w * r * ww.w); ((u32x2*)o)[lane + 64 * j] = q; }
}
template <bool INF32>
DI void rowpass_t(int gw, int ngw, int lane, const bf16* MF, const float* Hf, const bf16* Hb, float* HOf, bf16* HOb, const float* wa, const float* wb, float* RS) {
    u32x2 mq[8], hq[8]; f32x4 hf[8];
    int row = gw;
    if (row < MTOK) {
#pragma unroll
        for (int j = 0; j < 8; ++j) { mq[j] = ((const u32x2*)(MF + (size_t)row * DM))[lane + 64 * j]; if (INF32) hf[j] = ((const f32x4*)(Hf + (size_t)row * DM))[lane + 64 * j]; else hq[j] = ((const u32x2*)(Hb + (size_t)row * DM))[lane + 64 * j]; }
    }
    for (; row < MTOK; row += ngw) {
        f32x4 v[8], h[8];
#pragma unroll
        for (int j = 0; j < 8; ++j) { v[j] = (f32x4){bflo(mq[j].x), bfhi(mq[j].x), bflo(mq[j].y), bfhi(mq[j].y)}; h[j] = INF32 ? hf[j] : (f32x4){bflo(hq[j].x), bfhi(hq[j].x), bflo(hq[j].y), bfhi(hq[j].y)}; }
        const int nrow = row + ngw;
        if (nrow < MTOK) {
#pragma unroll
            for (int j = 0; j < 8; ++j) { mq[j] = ((const u32x2*)(MF + (size_t)nrow * DM))[lane + 64 * j]; if (INF32) hf[j] = ((const f32x4*)(Hf + (size_t)nrow * DM))[lane + 64 * j]; else hq[j] = ((const u32x2*)(Hb + (size_t)nrow * DM))[lane + 64 * j]; }
        }
        const float r = 1.f / sqrtf(row_ss(v) * (1.f / DM) + EPS);
#pragma unroll
        for (int j = 0; j < 8; ++j) { const f32x4 ww = ((const f32x4*)wa)[lane + 64 * j]; h[j] = h[j] + v[j] * r * ww; }
        if (HOf) {
#pragma unroll
            for (int j = 0; j < 8; ++j) ((f32x4*)(HOf + (size_t)row * DM))[lane + 64 * j] = h[j];
        } else {
#pragma unroll
            for (int j = 0; j < 8; ++j) { u32x2 q; q.x = pk2(h[j].x, h[j].y); q.y = pk2(h[j].z, h[j].w); ((u32x2*)(HOb + (size_t)row * DM))[lane + 64 * j] = q; } }
        if (wb) { const float r2 = 1.f / sqrtf(row_ss(h) * (1.f / DM) + EPS); if (lane == 0) RS[row] = r2; }
    }
}
DI void rowpass(int gw, int ngw, int lane, const bf16* MF, const float* Hf, const bf16* Hb, float* HOf, bf16* HOb, const float* wa, const float* wb, float* RS) {
    if (Hf) rowpass_t<true>(gw, ngw, lane, MF, Hf, Hb, HOf, HOb, wa, wb, RS); else rowpass_t<false>(gw, ngw, lane, MF, Hf, Hb, HOf, HOb, wa, wb, RS);
}

DI void transpose_jobs(const Args& a, unsigned char* ws, LAS float* scr, int lane, int wi, int nw, int j0, int j1) {
    const int gw = wi, NGW = nw;
    for (int j = j0; j < j1; ++j) {
        TJob J; J.mode = 0; J.drow0 = 0; J.c0 = 0; J.nk = nullptr;
        if (j < 6)       { const int l = j / 3, w = j % 3; J.W = a.in[2] + (size_t)l * DM * 7184; J.K = DM; J.ldn = 7184; J.nk = a.in[1] + (size_t)((2 * l) * 4 + 0) * DM;
                           if (w == 0) { J.c0 = 0; J.nc = 4096; J.WT = (bf16*)(ws + WS_WAB_IN) + (size_t)l * N_AB * DM; J.drow0 = 0; }
                           else if (w == 1) { J.c0 = 4112; J.nc = 3072; J.WT = (bf16*)(ws + WS_WAB_IN) + (size_t)l * N_AB * DM; J.drow0 = 4096; }
                           else { J.c0 = 4096; J.nc = 16; J.WT = (bf16*)(ws + WS_WAB_S) + (size_t)l * 16 * DM; J.drow0 = 0; } }
        else if (j < 8)  { J.W = a.in[3] + (size_t)(j - 6) * DM * DM; J.K = DM; J.ldn = DM; J.nc = DM; J.WT = (bf16*)(ws + WS_WAB_OUT) + (size_t)(j - 6) * DM * DM; }
        else if (j < 12) { const int l = (j - 8) >> 1, w = (j - 8) & 1; J.W = a.in[9] + (size_t)l * DM * 5168; J.K = DM; J.ldn = 5168; J.nk = a.in[1] + (size_t)((2 * l + 1) * 4 + 0) * DM;
                           if (w == 0) { J.nc = 5120; J.WT = (bf16*)(ws + WS_WNSA_IN) + (size_t)l * N_NSA * DM; }
                           else { J.c0 = 5120; J.nc = 48; J.WT = (bf16*)(ws + WS_WNSA_S) + (size_t)l * 48 * DM; } }
        else if (j < 14) { J.W = a.in[10] + (size_t)(j - 12) * DM * DM; J.K = DM; J.ldn = DM; J.nc = DM; J.WT = (bf16*)(ws + WS_WNSA_OUT) + (size_t)(j - 12) * DM * DM; }
        else if (j < 16) { J.W = a.in[12] + (size_t)(j - 14) * 4096 * 256; J.K = 4096; J.ldn = 256; J.nc = 256; J.WT = (bf16*)(ws + WS_WC1) + (size_t)((j - 14) * 2 + 0) * 256 * 4096; }
        else if (j < 18) { J.W = a.in[15] + (size_t)(j - 16) * 4096 * 256; J.K = 4096; J.ldn = 256; J.nc = 256; J.WT = (bf16*)(ws + WS_WC1) + (size_t)((j - 16) * 2 + 1) * 256 * 4096; }
        else if (j < 20) { J.W = a.in[13] + (size_t)(j - 18) * 256 * 128; J.K = 256; J.ldn = 128; J.nc = 128; J.WT = (bf16*)(ws + WS_WC2) + (size_t)((j - 18) * 2 + 0) * 256 * 256; }
        else if (j < 22) { J.W = a.in[16] + (size_t)(j - 20) * 256 * 128; J.K = 256; J.ldn = 128; J.nc = 128; J.WT = (bf16*)(ws + WS_WC2) + (size_t)((j - 20) * 2 + 1) * 256 * 256; }
        else if (j < 26) { J.nk = a.in[1] + (size_t)((j - 22) * 4 + 2) * DM; J.W = a.in[17] + (size_t)(j - 22) * DM * 2 * DFF; J.K = DM; J.ldn = 2 * DFF; J.nc = 2 * DFF; J.WT = (bf16*)(ws + WS_WGU) + (size_t)(j - 22) * 2 * DFF * DM; J.mode = 2; }
        else             { J.W = a.in[19] + (size_t)(j - 26) * DFF * DM; J.K = DFF; J.ldn = DM; J.nc = DM; J.WT = (bf16*)(ws + WS_WDN) + (size_t)(j - 26) * DM * DFF; }
        const int nitems = (J.K / 64) * ((J.nc + 63) / 64);
        f32x4 va[16], vb[16];
        int it = gw;
        if (it < nitems) transpose_load(J, it, lane, va);
        while (it < nitems) {
            const int it1 = it + NGW, it2 = it + 2 * NGW;
            if (it1 < nitems) transpose_load(J, it1, lane, vb);
            transpose_store(J, it, lane, va, scr);
            if (it1 >= nitems) break;
            if (it2 < nitems) transpose_load(J, it2, lane, va);
            transpose_store(J, it1, lane, vb, scr);
            it = it2;
        }
    }
}

DI void p0_prologue(const Args& a, unsigned char* ws, LAS unsigned char* lds, int tid, int lane, int wave, int G, int blk) {
    LAS float* scr = (LAS float*)(lds + wave * 16640);
    const int gw = blk * NWAVES + wave, NGW = G * NWAVES;
    const size_t gtid = (size_t)blk * NTHR + tid, gthreads = (size_t)G * NTHR;
    transpose_jobs(a, ws, scr, lane, gw, NGW, 0, G == 256 ? 22 : 30);
    for (int q = 0; q < 4; ++q) zero_fill16((bf16*)(ws + WS_WC2) + ((size_t)q * 256 + 128) * 256, (size_t)128 * 256 * 2, gtid, gthreads);
    for (int o = gw; o < 1024; o += NGW) {
        const int q = o >> 8, n = o & 255, l = q >> 1, isv = q & 1;
        const float* pos = a.in[isv ? 14 : 11] + (size_t)l * 4096; const float* w1 = a.in[isv ? 15 : 12] + (size_t)l * 4096 * 256;
        float s = 0.f;
#pragma unroll 1
        for (int k0 = 0; k0 < 4096; k0 += 1024) {
            float pv[16], wv[16];
#pragma unroll
            for (int i = 0; i < 16; ++i) { const int k = k0 + lane + 64 * i; pv[i] = pos[k]; wv[i] = w1[(size_t)k * 256 + n]; }
#pragma unroll
            for (int i = 0; i < 16; ++i) s += pv[i] * wv[i];
        }
        s = wave_sum(s); if (lane == 0) ((float*)(ws + WS_CBIAS))[o] = s;
    }
    for (size_t i = gtid; i < (size_t)SEQ * 64; i += gthreads) {
        const int t = (int)(i >> 6), f = (int)(i & 63);
        const float inv = exp2f(-(float)(2 * f) * (13.287712379549449f / 128.0f));
        const float ang = (float)t * inv;
        const float nrev = rintf(ang * 0.15915494309189535f); float r = fmaf(-nrev, 6.2831854820251465f, ang); r = fmaf(-nrev, -1.7484555e-7f, r);
        ((float*)(ws + WS_ROPE))[i] = cosf(r); ((float*)(ws + WS_ROPE))[(size_t)SEQ * 64 + i] = sinf(r);
    }
    const float* x = a.in[0]; const float* w00 = a.in[1];
    for (int row = gw; row < MTOK; row += NGW) {
        f32x4 v[8]; load_row(x + (size_t)row * DM, lane, v);
        const float r = 1.f / sqrtf(row_ss(v) * (1.f / DM) + EPS);
        { bf16* o = (bf16*)(ws + WS_XN) + (size_t)row * DM;
#pragma unroll
          for (int j = 0; j < 8; ++j) { u32x2 q; q.x = pk2(v[j].x, v[j].y); q.y = pk2(v[j].z, v[j].w); ((u32x2*)o)[lane + 64 * j] = q; }
          if (lane == 0) ((float*)(ws + WS_RS))[row] = r; }
    }
}

#ifndef NARROW_U1
#define NARROW_U1 16
#endif
#ifndef NARROW_U3
#define NARROW_U3 4
#endif
template <int NT> DI void narrow_gemm(LAS unsigned char* lds, int qp, int tid, const bf16* XN, const bf16* Ws, float* OUT, const float* RS) {
    const int lane = tid & 63, wave = tid >> 6, fr = lane & 15, fq = lane >> 4, rt = wave & 3, kh = wave >> 2, r0 = qp * 64 + 16 * rt;
    const bf16* a0 = XN + (size_t)(r0 + fr) * DM + kh * 1024 + 8 * fq; const bf16* bp = Ws + (size_t)fr * DM + kh * 1024 + 8 * fq;
    constexpr int U = NT == 1 ? NARROW_U1 : NARROW_U3, NG = 32 / U;
    f32x4 acc2[NT][2];
#pragma unroll
    for (int ct = 0; ct < NT; ++ct) { acc2[ct][0] = (f32x4){0.f, 0.f, 0.f, 0.f}; acc2[ct][1] = (f32x4){0.f, 0.f, 0.f, 0.f}; }
#pragma unroll
    for (int g = 0; g < NG; ++g) {
        bf16x8 Af[U], Bf[U][NT];
#pragma unroll
        for (int u = 0; u < U; ++u) { const int kk = g * U + u; Af[u] = *(const bf16x8*)(a0 + 32 * kk);
#pragma unroll
            for (int ct = 0; ct < NT; ++ct) Bf[u][ct] = *(const bf16x8*)(bp + (size_t)ct * 16 * DM + 32 * kk); }
#pragma unroll
        for (int u = 0; u < U; ++u)
#pragma unroll
            for (int ct = 0; ct < NT; ++ct) acc2[ct][u & 1] = MFMA16(Af[u], Bf[u][ct], acc2[ct][u & 1]);
        __builtin_amdgcn_sched_group_barrier(0x020, U * (1 + NT), 0);
        __builtin_amdgcn_sched_group_barrier(0x008, U * NT, 0);
    }
    f32x4 acc[NT];
#pragma unroll
    for (int ct = 0; ct < NT; ++ct) acc[ct] = acc2[ct][0] + acc2[ct][1];
    LAS f32x4* X = (LAS f32x4*)lds;
    if (kh == 1) {
#pragma unroll
        for (int ct = 0; ct < NT; ++ct) X[(rt * NT + ct) * 64 + lane] = acc[ct]; }
    __syncthreads();
    if (kh == 0) {
#pragma unroll
        for (int ct = 0; ct < NT; ++ct) { const f32x4 o = acc[ct] + X[(rt * NT + ct) * 64 + lane];
#pragma unroll
            for (int r = 0; r < 4; ++r) OUT[(size_t)(r0 + 4 * fq + r) * (16 * NT) + 16 * ct + fr] = o[r] * RS[r0 + 4 * fq + r]; } }
    __syncthreads();
}

DI void ldcol0(f32x4 (&c)[4], const LAS float* a) { asm volatile("ds_read_b128 %0, %4 offset:0\n\tds_read_b128 %1, %4 offset:16\n\tds_read_b128 %2, %4 offset:32\n\tds_read_b128 %3, %4 offset:48" : "=&v"(c[0]), "=&v"(c[1]), "=&v"(c[2]), "=&v"(c[3]) : "v"(a)); }
DI void ldcol4(f32x4 (&c)[4], const LAS float* a) { asm volatile("ds_read_b128 %0, %4 offset:64\n\tds_read_b128 %1, %4 offset:80\n\tds_read_b128 %2, %4 offset:96\n\tds_read_b128 %3, %4 offset:112" : "=&v"(c[0]), "=&v"(c[1]), "=&v"(c[2]), "=&v"(c[3]) : "v"(a)); }
DI void ldcol8(f32x4 (&c)[4], const LAS float* a) { asm volatile("ds_read_b128 %0, %4 offset:128\n\tds_read_b128 %1, %4 offset:144\n\tds_read_b128 %2, %4 offset:160\n\tds_read_b128 %3, %4 offset:176" : "=&v"(c[0]), "=&v"(c[1]), "=&v"(c[2]), "=&v"(c[3]) : "v"(a)); }
DI void ldcol12(f32x4 (&c)[4], const LAS float* a) { asm volatile("ds_read_b128 %0, %4 offset:192\n\tds_read_b128 %1, %4 offset:208\n\tds_read_b128 %2, %4 offset:224\n\tds_read_b128 %3, %4 offset:240" : "=&v"(c[0]), "=&v"(c[1]), "=&v"(c[2]), "=&v"(c[3]) : "v"(a)); }
DI void ldcol_wait8(f32x4 (&c)[4]) { asm volatile("s_waitcnt lgkmcnt(8)" : "+v"(c[0]), "+v"(c[1]), "+v"(c[2]), "+v"(c[3])); }
DI void ldcol_wait4(f32x4 (&c)[4]) { asm volatile("s_waitcnt lgkmcnt(4)" : "+v"(c[0]), "+v"(c[1]), "+v"(c[2]), "+v"(c[3])); }
DI void ldcol_wait0(f32x4 (&c)[4]) { asm volatile("s_waitcnt lgkmcnt(0)" : "+v"(c[0]), "+v"(c[1]), "+v"(c[2]), "+v"(c[3])); }
template <int GB> DI void ldcol(f32x4 (&c)[4], const LAS float* a) { if (GB == 0) ldcol0(c, a); else if (GB == 4) ldcol4(c, a); else if (GB == 8) ldcol8(c, a); else ldcol12(c, a); }
DI void ldhalf_0(f32x4 (&c)[2], const LAS float* a) { asm volatile("ds_read_b128 %0, %2 offset:0\n\tds_read_b128 %1, %2 offset:16" : "=&v"(c[0]), "=&v"(c[1]) : "v"(a)); }
DI void ldhalf_2(f32x4 (&c)[2], const LAS float* a) { asm volatile("ds_read_b128 %0, %2 offset:32\n\tds_read_b128 %1, %2 offset:48" : "=&v"(c[0]), "=&v"(c[1]) : "v"(a)); }
DI void ldhalf_4(f32x4 (&c)[2], const LAS float* a) { asm volatile("ds_read_b128 %0, %2 offset:64\n\tds_read_b128 %1, %2 offset:80" : "=&v"(c[0]), "=&v"(c[1]) : "v"(a)); }
DI void ldhalf_6(f32x4 (&c)[2], const LAS float* a) { asm volatile("ds_read_b128 %0, %2 offset:96\n\tds_read_b128 %1, %2 offset:112" : "=&v"(c[0]), "=&v"(c[1]) : "v"(a)); }
DI void ldhalf_8(f32x4 (&c)[2], const LAS float* a) { asm volatile("ds_read_b128 %0, %2 offset:128\n\tds_read_b128 %1, %2 offset:144" : "=&v"(c[0]), "=&v"(c[1]) : "v"(a)); }
DI void ldhalf_10(f32x4 (&c)[2], const LAS float* a) { asm volatile("ds_read_b128 %0, %2 offset:160\n\tds_read_b128 %1, %2 offset:176" : "=&v"(c[0]), "=&v"(c[1]) : "v"(a)); }
DI void ldhalf_12(f32x4 (&c)[2], const LAS float* a) { asm volatile("ds_read_b128 %0, %2 offset:192\n\tds_read_b128 %1, %2 offset:208" : "=&v"(c[0]), "=&v"(c[1]) : "v"(a)); }
DI void ldhalf_14(f32x4 (&c)[2], const LAS float* a) { asm volatile("ds_read_b128 %0, %2 offset:224\n\tds_read_b128 %1, %2 offset:240" : "=&v"(c[0]), "=&v"(c[1]) : "v"(a)); }
DI void ldhalf_wait2(f32x4 (&c)[2]) { asm volatile("s_waitcnt lgkmcnt(2)" : "+v"(c[0]), "+v"(c[1])); }
DI void ldhalf_wait0(f32x4 (&c)[2]) { asm volatile("s_waitcnt lgkmcnt(0)" : "+v"(c[0]), "+v"(c[1])); }
template <int G> DI void ldhalf(f32x4 (&c)[2], const LAS float* a) {
    if (G == 0) ldhalf_0(c, a); else if (G == 2) ldhalf_2(c, a); else if (G == 4) ldhalf_4(c, a); else if (G == 6) ldhalf_6(c, a); else if (G == 8) ldhalf_8(c, a); else if (G == 10) ldhalf_10(c, a); else if (G == 12) ldhalf_12(c, a); else ldhalf_14(c, a); }
template <int J0, int J1, int GB, bool DENSE>
DI void solve_cols(float (&x)[64], const LAS float* LT) {
    f32x4 c[2][2];
    ldhalf<GB>(c[0], LT + J0 * 68); ldhalf<GB + 2>(c[1], LT + J0 * 68);
#pragma unroll
    for (int j = J0; j < J1; ++j) {
        const float xj = x[j];
#pragma unroll
        for (int h = 0; h < 2; ++h) {
            if (h == 0) { ldhalf_wait2(c[0]); } else { if (j + 1 < J1) ldhalf_wait2(c[1]); else ldhalf_wait0(c[1]); }
#pragma unroll
            for (int k = 0; k < 2; ++k) if (DENSE || GB + 2 * h + k >= ((j + 1) >> 2)) {
#pragma unroll
                for (int r = 0; r < 4; ++r) x[4 * (GB + 2 * h + k) + r] = fmaf(-c[h][k][r], xj, x[4 * (GB + 2 * h + k) + r]); }
            if (j + 1 < J1) { asm volatile("" : "+v"(x[4 * (GB + 2 * h)]), "+v"(x[4 * (GB + 2 * h) + 7]));
                if (h == 0) ldhalf<GB>(c[0], LT + (j + 1) * 68); else ldhalf<GB + 2>(c[1], LT + (j + 1) * 68); }
        }
    }
}
DI void gdn_prep(LAS unsigned char* lds, int tid_in, int lane_in, int wave, int G, int blk, const bf16* PROJ, const float* SMALL, const float* convw, const float* a_log, const float* dt_bias, unsigned char* ops, float* EG) {
    LAS float* LK = (LAS float*)(lds + 0);
    LAS float* SC = (LAS float*)(lds + 17408);
    LAS float* LQ = (LAS float*)(lds + 19456);
    LAS bf16* QR = (LAS bf16*)(lds + 36864);
    LAS bf16* KR = (LAS bf16*)(lds + 54272);
    LAS bf16* WB = (LAS bf16*)(lds + 71680);
    LAS bf16* XIN = (LAS bf16*)(lds + 89088);
    for (int item = blk; item < 2048; item += G) {
        int tid = tid_in; asm volatile("" : "+v"(tid)); const int lane = tid & 63, fr = lane & 15, fq = lane >> 4;
        const int b = item >> 9, h = (item >> 6) & 7, n = item & 63;
        const size_t row0 = (size_t)b * SEQ + (size_t)n * 64;
        unsigned char* op = ops + (size_t)item * GOP_BYTES;
        float cw0 = 0.f, cw1 = 0.f, cw2 = 0.f, cw3 = 0.f;
        if (tid < 384) { const int col = (tid < 128 ? 2 : (tid < 256 ? 1 : 0)) * 1024 + h * 128 + (tid & 127); cw0 = convw[col]; cw1 = convw[3072 + col]; cw2 = convw[6144 + col]; cw3 = convw[9216 + col]; }
        else if (tid < 448) { const float* p = SMALL + (row0 + (tid - 384)) * 16; cw0 = p[h]; cw1 = p[8 + h]; cw2 = dt_bias[h]; cw3 = a_log[h]; }
        {
            u32x4 xv[7];
#pragma unroll
            for (int k = 0; k < 7; ++k) {
                const int e = tid + NTHR * k, r = e / 48, sgm = (e % 48) >> 4, ch = e & 15;
                xv[k] = (u32x4){0u, 0u, 0u, 0u};
                if (e < 67 * 48 && (n > 0 || r >= 3)) xv[k] = *(const u32x4*)(PROJ + (row0 + r - 3) * LDP_AB + sgm * 1024 + h * 128 + ch * 8);
            }
#pragma unroll
            for (int k = 0; k < 7; ++k) {
                const int e = tid + NTHR * k, r = e / 48, sgm = (e % 48) >> 4, ch = e & 15;
                if (e < 67 * 48) *(LAS u32x4*)(XIN + r * 384 + sgm * 128 + ch * 8) = xv[k];
            }
        }
        lds_barrier();
        float x[64];
        const int c = tid & 127;
        if (tid < 384) {
            const int which = tid < 128 ? 2 : (tid < 256 ? 1 : 0), col = which * 1024 + h * 128 + c;
            const float w0 = cw0, w1 = cw1, w2 = cw2, w3 = cw3; (void)col;
            const LAS bf16* p = XIN + which * 128 + c;
            float x0 = bf2f(p[0]), x1 = bf2f(p[384]), x2 = bf2f(p[768]);
#pragma unroll
            for (int t = 0; t < 64; ++t) { const float x3 = bf2f(p[(t + 3) * 384]); x[t] = silu_f(w0 * x0 + w1 * x1 + w2 * x2 + w3 * x3); x0 = x1; x1 = x2; x2 = x3; }
            if (which != 2) { LAS bf16* dst = which == 1 ? KR : QR;
#pragma unroll
                for (int t = 0; t < 64; ++t) dst[t * 136 + c] = f2bf(x[t]); }
        } else if (tid < 448) {
            const int t = tid - 384;
            const float av = cw0 + cw2, bv = cw1;
            const float sp = fmaxf(av, 0.f) + __logf(1.f + __expf(-fabsf(av)));
            SC[t] = -__expf(cw3) * sp; SC[64 + t] = sigmoid_f(bv);
        }
        lds_barrier();
        if (wave == 7) { float g = SC[lane];
#pragma unroll
            for (int o = 1; o < 64; o <<= 1) { const float t = __shfl_up(g, o); if (lane >= o) g += t; }
            SC[128 + lane] = g; }
#pragma unroll
        for (int i = 0; i < 4; ++i) {
            const int task = wave * 4 + i, mat = task >> 4, it = (task >> 2) & 3, jt = task & 3;
            if (it >= jt) {
                const LAS bf16* As = (mat ? QR : KR) + (16 * it + fr) * 136 + fq * 8; const LAS bf16* Bs = KR + (16 * jt + fr) * 136 + fq * 8;
                f32x4 acc = {0.f, 0.f, 0.f, 0.f};
#pragma unroll
                for (int kk = 0; kk < 4; ++kk) acc = MFMA16(*(const LAS bf16x8*)(As + kk * 32), *(const LAS bf16x8*)(Bs + kk * 32), acc);
                LAS float* dst = (mat ? LQ : LK) + (16 * it + 4 * fq) * 68 + 16 * jt + fr;
#pragma unroll
                for (int r = 0; r < 4; ++r) dst[r * 68] = acc[r];
            }
        }
        if (wave < 4) {
            const LAS bf16* As = QR + (16 * wave + fr) * 136 + fq * 8;
            f32x4 acc = {0.f, 0.f, 0.f, 0.f};
#pragma unroll
            for (int kk = 0; kk < 4; ++kk) { const bf16x8 av = *(const LAS bf16x8*)(As + kk * 32); acc = MFMA16(av, av, acc); }
#pragma unroll
            for (int r = 0; r < 4; ++r) if (fr == 4 * fq + r) SC[320 + 16 * wave + fr] = acc[r];
        }
        lds_barrier();
        if (tid < 64) { const float rk = 1.f / sqrtf(LK[tid * 68 + tid] + EPS); SC[192 + tid] = rk; SC[384 + tid] = rk * SC[64 + tid] * __expf(SC[128 + tid]); SC[256 + tid] = 0.08838834764831845f / sqrtf(SC[320 + tid] + EPS); }
        lds_barrier();
        {
            bf16* QKf = (bf16*)(op + 49152);
            LAS float* LT = (LAS float*)(lds + 89088);
#pragma unroll
            for (int k = 0; k < 8; ++k) {
                const int e = tid + 512 * k, i = e >> 6, j = e & 63;
                const float dec = (i >= j) ? __expf(SC[128 + i] - SC[128 + j]) : 0.f;
                const float lk = LK[i * 68 + j], lq = LQ[i * 68 + j];
                const float Lv = (i > j) ? SC[64 + i] * SC[192 + i] * SC[192 + j] * lk * dec : 0.f;
                const float qk = (i >= j) ? SC[256 + i] * SC[192 + j] * lq * dec : 0.f;
                LT[j * 68 + i] = Lv;
                QKf[(((i >> 4) * 2 + (j >> 5)) * 64 + ((j >> 2) & 3) * 16 + (i & 15)) * 8 + ((j >> 4) & 1) * 4 + (j & 3)] = f2bf(qk);
            }
        }
        lds_barrier();
        if (tid < 256) {
            {
                const LAS float* sv = SC + (tid < 128 ? 64 : 384);
#pragma unroll
                for (int i = 0; i < 64; ++i) x[i] *= sv[i];
            }
            {
                const LAS float* LT = (const LAS float*)(lds + 89088); asm volatile("" : "+v"(LT));
                solve_cols<0, 15, 0, false>(x, LT);
                solve_cols<0, 16, 4, true>(x, LT);  solve_cols<16, 31, 4, false>(x, LT);
                solve_cols<0, 32, 8, true>(x, LT);  solve_cols<32, 47, 8, false>(x, LT);
                solve_cols<0, 48, 12, true>(x, LT); solve_cols<48, 63, 12, false>(x, LT);
            }
            if (tid < 128) { u32x2* UT = (u32x2*)(op + 57344) + c;
#pragma unroll
                for (int i = 0; i < 16; ++i) UT[i * 128] = (u32x2){pk2(x[4 * i], x[4 * i + 1]), pk2(x[4 * i + 2], x[4 * i + 3])};
            } else {
#pragma unroll
                for (int i = 0; i < 64; ++i) WB[i * 136 + c] = f2bf(x[i]);
            }
        } else {
            const int w4 = wave - 4;
            const float glast = SC[128 + 63];
#pragma unroll
            for (int i = 0; i < 4; ++i) {
                const int f = w4 * 4 + i, mt = f >> 2, kk = f & 3, tok = 16 * mt + fr;
                const float sc = SC[256 + tok] * __expf(SC[128 + tok]);
                const LAS bf16* s = QR + tok * 136 + 32 * kk + 4 * fq;
                const u32x2 lo = *(const LAS u32x2*)s, hi = *(const LAS u32x2*)(s + 16);
                u32x4 o; o.x = pk2(bflo(lo.x) * sc, bfhi(lo.x) * sc); o.y = pk2(bflo(lo.y) * sc, bfhi(lo.y) * sc); o.z = pk2(bflo(hi.x) * sc, bfhi(hi.x) * sc); o.w = pk2(bflo(hi.y) * sc, bfhi(hi.y) * sc);
                ((u32x4*)(op + 16384))[f * 64 + lane] = o;
            }
#pragma unroll
            for (int i = 0; i < 4; ++i) {
                const int f = w4 * 4 + i, dt = f >> 1, kk2 = f & 1, d = 16 * dt + fr;
                float v[8];
#pragma unroll
                for (int j = 0; j < 8; ++j) { const int tok = 32 * kk2 + 16 * (j >> 2) + 4 * fq + (j & 3); v[j] = bf2f(KR[tok * 136 + d]) * SC[192 + tok] * __expf(glast - SC[128 + tok]); }
                u32x4 o; o.x = pk2(v[0], v[1]); o.y = pk2(v[2], v[3]); o.z = pk2(v[4], v[5]); o.w = pk2(v[6], v[7]);
                ((u32x4*)(op + 32768))[f * 64 + lane] = o;
            }
            if (tid == 256) EG[item] = __expf(glast);
        }
        lds_barrier();
#pragma unroll
        for (int i = 0; i < 2; ++i) {
            const int f = wave * 2 + i, mt = f >> 2, kk = f & 3, tok = 16 * mt + fr;
            const LAS bf16* s = WB + tok * 136 + 32 * kk + 4 * fq;
            const u32x2 lo = *(const LAS u32x2*)s, hi = *(const LAS u32x2*)(s + 16);
            u32x4 o; o.x = lo.x; o.y = lo.y; o.z = hi.x; o.w = hi.y;
            ((u32x4*)op)[f * 64 + lane] = o;
        }
        lds_barrier();
    }
}

DI void scan_chunk(LAS unsigned char* L, int lane, int wave, int fr, int fq, f32x4 (&S)[8], float eg, bf16* o0) {
    const LAS bf16x8* Wf = (const LAS bf16x8*)L; const LAS bf16x8* Qf = (const LAS bf16x8*)(L + 16384); const LAS bf16x8* KDf = (const LAS bf16x8*)(L + 32768); const LAS bf16x8* QKf = (const LAS bf16x8*)(L + 49152);
    const LAS u32x2* UT = (const LAS u32x2*)(L + 57344);
    bf16x8 Sb[4];
#pragma unroll
    for (int kk = 0; kk < 4; ++kk) Sb[kk] = pack8(S[2 * kk], S[2 * kk + 1]);
    f32x4 vn[4];
    {
        bf16x8 wf[16]; f32x4 ut[4];
#pragma unroll
        for (int i = 0; i < 16; ++i) wf[i] = Wf[i * 64 + lane];
        f32x4 acc[4];
#pragma unroll
        for (int mt = 0; mt < 4; ++mt) acc[mt] = (f32x4){0.f, 0.f, 0.f, 0.f};
#pragma unroll
        for (int kk = 0; kk < 4; ++kk)
#pragma unroll
            for (int mt = 0; mt < 4; ++mt) acc[mt] = MFMA16(wf[mt * 4 + kk], Sb[kk], acc[mt]);
#pragma unroll
        for (int mt = 0; mt < 4; ++mt) { const u32x2 q = UT[(mt * 4 + fq) * 32 + 16 * wave + fr]; ut[mt] = (f32x4){bflo(q.x), bfhi(q.x), bflo(q.y), bfhi(q.y)}; }
        __builtin_amdgcn_sched_group_barrier(0x100, 16, 0);
        __builtin_amdgcn_sched_group_barrier(0x008, 8, 0);
        __builtin_amdgcn_sched_group_barrier(0x100, 4, 0);
        __builtin_amdgcn_sched_group_barrier(0x008, 8, 0);
#pragma unroll
        for (int mt = 0; mt < 4; ++mt) vn[mt] = ut[mt] - acc[mt];
    }
    bf16x8 Vb[2]; Vb[0] = pack8(vn[0], vn[1]); Vb[1] = pack8(vn[2], vn[3]);
    {
        f32x4 acc[4];
#pragma unroll
        for (int mt = 0; mt < 4; ++mt) acc[mt] = (f32x4){0.f, 0.f, 0.f, 0.f};
        {
            bf16x8 qf[16];
#pragma unroll
            for (int i = 0; i < 16; ++i) qf[i] = Qf[i * 64 + lane];
#pragma unroll
            for (int kk = 0; kk < 4; ++kk)
#pragma unroll
                for (int mt = 0; mt < 4; ++mt) acc[mt] = MFMA16(qf[mt * 4 + kk], Sb[kk], acc[mt]);
            __builtin_amdgcn_sched_group_barrier(0x100, 16, 0);
            __builtin_amdgcn_sched_group_barrier(0x008, 16, 0);
        }
        {
            bf16x8 qk[8];
#pragma unroll
            for (int i = 0; i < 8; ++i) qk[i] = QKf[i * 64 + lane];
#pragma unroll
            for (int k2 = 0; k2 < 2; ++k2)
#pragma unroll
                for (int mt = 0; mt < 4; ++mt) acc[mt] = MFMA16(qk[mt * 2 + k2], Vb[k2], acc[mt]);
            __builtin_amdgcn_sched_group_barrier(0x100, 8, 0);
            __builtin_amdgcn_sched_group_barrier(0x008, 8, 0);
        }
#pragma unroll
        for (int mt = 0; mt < 4; ++mt) { bf16* o = o0 + (size_t)(16 * mt) * 1024;
#pragma unroll
            for (int r = 0; r < 4; ++r) o[(size_t)r * 1024] = f2bf(acc[mt][r]); }
    }
    {
        bf16x8 kd[16];
#pragma unroll
        for (int i = 0; i < 16; ++i) kd[i] = KDf[i * 64 + lane];
#pragma unroll
        for (int dt = 0; dt < 8; ++dt) S[dt] = S[dt] * eg;
#pragma unroll
        for (int k2 = 0; k2 < 2; ++k2)
#pragma unroll
            for (int dt = 0; dt < 8; ++dt) S[dt] = MFMA16(kd[dt * 2 + k2], Vb[k2], S[dt]);
        __builtin_amdgcn_sched_group_barrier(0x100, 16, 0);
        __builtin_amdgcn_sched_group_barrier(0x008, 16, 0);
    }
}
DI void gdn_scan(LAS unsigned char* lds, int tid, int lane, int wave, int G, int blk, const unsigned char* ops, const float* EG, bf16* O) {
    const int fr = lane & 15, fq = lane >> 4;
    for (int task = blk; task < 128; task += G) {
        const int xcd = task & 7, idx = task >> 3, bh = xcd + 8 * (idx >> 2), q4 = idx & 3, b = bh >> 3, h = bh & 7;
        const unsigned char* base0 = ops + (size_t)(bh * 64) * GOP_BYTES;
        const unsigned utoff = 57344u + (unsigned)(((tid >> 5) * 128 + q4 * 32 + (tid & 31)) * 8), toff = (unsigned)tid * 16u;
        u32x4 pr[8], pq[8]; float eg = EG[bh * 64], egn = 0.f, egq = 0.f;
#pragma unroll
        for (int j = 0; j < 7; ++j) pr[j] = *(const u32x4*)(base0 + 8192 * j + toff);
        { const u32x2 q = *(const u32x2*)(base0 + utoff); pr[7] = (u32x4){q.x, q.y, 0u, 0u}; }
#pragma unroll
        for (int j = 0; j < 7; ++j) *(LAS u32x4*)(lds + 16 * (tid + 512 * j)) = pr[j];
        *(LAS u32x2*)(lds + 57344 + 8 * tid) = (u32x2){pr[7].x, pr[7].y};
        {
            const unsigned char* bp = base0 + GOP_BYTES;
#pragma unroll
            for (int j = 0; j < 7; ++j) pr[j] = *(const u32x4*)(bp + 8192 * j + toff);
            { const u32x2 q = *(const u32x2*)(bp + utoff); pr[7] = (u32x4){q.x, q.y, 0u, 0u}; }
            egn = EG[bh * 64 + 1];
        }
        __syncthreads();
        f32x4 S[8];
#pragma unroll
        for (int i = 0; i < 8; ++i) S[i] = (f32x4){0.f, 0.f, 0.f, 0.f};
#define SCAN_STEP(n, PN, PF, EGN, EGF) do { \
            if ((n) + 2 < 64) { \
                _Pragma("unroll") for (int j = 0; j < 7; ++j) PF[j] = *(const u32x4*)(bp + 8192 * j + toff); \
                { const u32x2 q_ = *(const u32x2*)(bp + utoff); PF[7] = (u32x4){q_.x, q_.y, 0u, 0u}; } \
                EGF = egp[(n) + 2]; \
            } \
            if (wave < 2) scan_chunk(lds + ((n) & 1) * 65536, lane, wave, fr, fq, S, eg, op); \
            if ((n) + 1 < 64) { \
                LAS unsigned char* Ln = lds + (((n) + 1) & 1) * 65536; \
                _Pragma("unroll") for (int j = 0; j < 7; ++j) *(LAS u32x4*)(Ln + 16 * (tid + 512 * j)) = PN[j]; \
                *(LAS u32x2*)(Ln + 57344 + 8 * tid) = (u32x2){PN[7].x, PN[7].y}; \
            } \
            eg = EGN; bp += GOP_BYTES; op += (size_t)64 * 1024; \
            __syncthreads(); } while (0)
        const unsigned char* bp = base0 + 2 * GOP_BYTES; const float* egp = EG + bh * 64;
        bf16* op = O + ((size_t)b * SEQ + 4 * fq) * 1024 + h * 128 + q4 * 32 + 16 * wave + fr;
#pragma unroll 1
        for (int n = 0; n < 64; n += 2) { SCAN_STEP(n, pr, pq, egn, egq); SCAN_STEP(n + 1, pq, pr, egq, egn); }
#undef SCAN_STEP
    }
}

struct GoutRow { u32x4 ob[2]; u32x4 z[2], hb[2], gc[2], gb[2]; };
DI void gout_load(GoutRow& R, const bf16* O, const bf16* PROJ, size_t row, int lane) {
    const u32x4* op = (const u32x4*)(O + row * 1024 + lane * 16); const bf16* pr = PROJ + row * LDP_AB + lane * 16;
#pragma unroll
    for (int i = 0; i < 2; ++i) R.ob[i] = op[i];
#pragma unroll
    for (int s = 0; s < 2; ++s) { R.z[s] = *(const u32x4*)(pr + 3072 + 8 * s); R.hb[s] = *(const u32x4*)(pr + 4096 + 8 * s); R.gb[s] = *(const u32x4*)(pr + 5120 + 8 * s); R.gc[s] = *(const u32x4*)(pr + 6144 + 8 * s); }
}
DI void unpack16(const u32x4 a, const u32x4 b, float (&f)[16]) {
    f[0] = bflo(a.x); f[1] = bfhi(a.x); f[2] = bflo(a.y); f[3] = bfhi(a.y); f[4] = bflo(a.z); f[5] = bfhi(a.z); f[6] = bflo(a.w); f[7] = bfhi(a.w);
    f[8] = bflo(b.x); f[9] = bfhi(b.x); f[10] = bflo(b.y); f[11] = bfhi(b.y); f[12] = bflo(b.z); f[13] = bfhi(b.z); f[14] = bflo(b.w); f[15] = bfhi(b.w);
}
DI void gdn_out(int gw, int ngw, int lane, const bf16* O, const bf16* PROJ, const float* onorm, const float* scw, bf16* Y) {
    float wn[16], w0[16], w1[16], w2[16];
#pragma unroll
    for (int i = 0; i < 16; ++i) { wn[i] = onorm[(lane & 7) * 16 + i]; w0[i] = scw[lane * 16 + i]; w1[i] = scw[1024 + lane * 16 + i]; w2[i] = scw[2048 + lane * 16 + i]; }
    for (int item = gw; item < MTOK / 8; item += ngw) {
        const size_t row0 = (size_t)item * 8; const int t0 = (int)(row0 & (SEQ - 1));
        float p1[16], p2[16];
#pragma unroll
        for (int i = 0; i < 16; ++i) { p1[i] = 0.f; p2[i] = 0.f; }
        if (t0 > 0) {
            const bf16* pa = PROJ + (row0 - 1) * LDP_AB + lane * 16; const bf16* pb = PROJ + (row0 - 2) * LDP_AB + lane * 16;
            float h[16], g[16];
            unpack16(*(const u32x4*)(pa + 4096), *(const u32x4*)(pa + 4096 + 8), h); unpack16(*(const u32x4*)(pa + 6144), *(const u32x4*)(pa + 6144 + 8), g);
#pragma unroll
            for (int i = 0; i < 16; ++i) p1[i] = h[i] * g[i];
            unpack16(*(const u32x4*)(pb + 4096), *(const u32x4*)(pb + 4096 + 8), h); unpack16(*(const u32x4*)(pb + 6144), *(const u32x4*)(pb + 6144 + 8), g);
#pragma unroll
            for (int i = 0; i < 16; ++i) p2[i] = h[i] * g[i];
        }
        GoutRow cur, nxt; gout_load(cur, O, PROJ, row0, lane);
#pragma unroll 1
        for (int rr = 0; rr < 8; ++rr) {
            const size_t row = row0 + rr;
            if (rr < 7) gout_load(nxt, O, PROJ, row + 1, lane);
            float of[16]; unpack16(cur.ob[0], cur.ob[1], of);
            float ss = 0.f;
#pragma unroll
            for (int i = 0; i < 4; ++i) ss += (of[4 * i] * of[4 * i] + of[4 * i + 1] * of[4 * i + 1]) + (of[4 * i + 2] * of[4 * i + 2] + of[4 * i + 3] * of[4 * i + 3]);
            ss += __shfl_xor(ss, 1); ss += __shfl_xor(ss, 2); ss += __shfl_xor(ss, 4);
            const float r = 1.f / sqrtf(ss * (1.f / 128.f) + EPS);
            float zz[16], y[16]; unpack16(cur.z[0], cur.z[1], zz);
#pragma unroll
            for (int i = 0; i < 16; ++i) y[i] = of[i] * r * wn[i] * silu_f(zz[i]);
            u32x4 q0, q1; q0.x = pk2(y[0], y[1]); q0.y = pk2(y[2], y[3]); q0.z = pk2(y[4], y[5]); q0.w = pk2(y[6], y[7]); q1.x = pk2(y[8], y[9]); q1.y = pk2(y[10], y[11]); q1.z = pk2(y[12], y[13]); q1.w = pk2(y[14], y[15]);
            u32x4* yo = (u32x4*)(Y + row * DM + lane * 16); yo[0] = q0; yo[1] = q1;
            float h[16], g[16], gb[16]; unpack16(cur.hb[0], cur.hb[1], h); unpack16(cur.gc[0], cur.gc[1], g); unpack16(cur.gb[0], cur.gb[1], gb);
#pragma unroll
            for (int i = 0; i < 16; ++i) { const float p0 = h[i] * g[i]; y[i] = gb[i] * (w0[i] * p2[i] + w1[i] * p1[i] + w2[i] * p0); p2[i] = p1[i]; p1[i] = p0; }
            q0.x = pk2(y[0], y[1]); q0.y = pk2(y[2], y[3]); q0.z = pk2(y[4], y[5]); q0.w = pk2(y[6], y[7]); q1.x = pk2(y[8], y[9]); q1.y = pk2(y[10], y[11]); q1.z = pk2(y[12], y[13]); q1.w = pk2(y[14], y[15]);
            yo = (u32x4*)(Y + row * DM + 1024 + lane * 16); yo[0] = q0; yo[1] = q1;
            cur = nxt;
        }
    }
}

DI void ffn_fix(int gtid, int gthreads, const float* SG, const float* S0, const float* cw, bf16* ACT) {
    for (int e = gtid; e < 64 * 2 * (DFF / 4); e += gthreads) {
        const int c4 = e % (DFF / 4), pr = e / (DFF / 4), r = pr & 1, pm = pr >> 1, ch = 4 * c4;
        if ((pm & 15) == 0) continue;
        const f32x4 gm2 = *(const f32x4*)(SG + ((size_t)(pm - 1) * 2 + 0) * DFF + ch), gm1 = *(const f32x4*)(SG + ((size_t)(pm - 1) * 2 + 1) * DFF + ch);
        const f32x4 g0 = *(const f32x4*)(S0 + (((size_t)pm * 2 + 0) * 2) * DFF + ch), g1 = *(const f32x4*)(S0 + (((size_t)pm * 2 + 1) * 2) * DFF + ch);
        const f32x4 up = *(const f32x4*)(S0 + (((size_t)pm * 2 + r) * 2 + 1) * DFF + ch);
        const f32x4 w0 = *(const f32x4*)(cw + ch), w1 = *(const f32x4*)(cw + DFF + ch), w2 = *(const f32x4*)(cw + 2 * DFF + ch);
        const f32x4 c = r == 0 ? (w0 * gm2 + w1 * gm1 + w2 * g0) : (w0 * gm1 + w1 * g0 + w2 * g1);
        u32x2 o; o.x = pk2(silu_f(c.x) * up.x, silu_f(c.y) * up.y); o.y = pk2(silu_f(c.z) * up.z, silu_f(c.w) * up.w);
        *(u32x2*)(ACT + (size_t)(pm * 256 + r) * DFF + ch) = o;
    }
}

DI void ffn_act(int gw, int ngw, int lane, const bf16* GU, const float* cw, bf16* ACT) {
    for (int item = gw; item < (MTOK / 16) * 11; item += ngw) {
        const int rb = item / 11, cg = item % 11, c0 = cg * 512 + lane * 8, row0 = rb * 16, t0 = row0 & (SEQ - 1);
        float w[3][8];
#pragma unroll
        for (int k = 0; k < 3; ++k) { const f32x4 a = *(const f32x4*)(cw + k * DFF + c0), bq = *(const f32x4*)(cw + k * DFF + c0 + 4); w[k][0] = a.x; w[k][1] = a.y; w[k][2] = a.z; w[k][3] = a.w; w[k][4] = bq.x; w[k][5] = bq.y; w[k][6] = bq.z; w[k][7] = bq.w; }
        const bf16* g = GU + (size_t)row0 * (2 * DFF) + c0;
        u32x4 p0 = {0u, 0u, 0u, 0u}, p1 = {0u, 0u, 0u, 0u};
        if (t0 > 0) { p0 = *(const u32x4*)(g - (size_t)2 * (2 * DFF)); p1 = *(const u32x4*)(g - (size_t)(2 * DFF)); }
#pragma unroll 4
        for (int r = 0; r < 16; ++r) {
            const u32x4 p2 = *(const u32x4*)(g + (size_t)r * (2 * DFF)); const u32x4 up = *(const u32x4*)(g + (size_t)r * (2 * DFF) + DFF);
            float a[8];
            a[0] = w[0][0] * bflo(p0.x) + w[1][0] * bflo(p1.x) + w[2][0] * bflo(p2.x); a[1] = w[0][1] * bfhi(p0.x) + w[1][1] * bfhi(p1.x) + w[2][1] * bfhi(p2.x);
            a[2] = w[0][2] * bflo(p0.y) + w[1][2] * bflo(p1.y) + w[2][2] * bflo(p2.y); a[3] = w[0][3] * bfhi(p0.y) + w[1][3] * bfhi(p1.y) + w[2][3] * bfhi(p2.y);
            a[4] = w[0][4] * bflo(p0.z) + w[1][4] * bflo(p1.z) + w[2][4] * bflo(p2.z); a[5] = w[0][5] * bfhi(p0.z) + w[1][5] * bfhi(p1.z) + w[2][5] * bfhi(p2.z);
            a[6] = w[0][6] * bflo(p0.w) + w[1][6] * bflo(p1.w) + w[2][6] * bflo(p2.w); a[7] = w[0][7] * bfhi(p0.w) + w[1][7] * bfhi(p1.w) + w[2][7] * bfhi(p2.w);
            u32x4 o;
            o.x = pk2(silu_f(a[0]) * bflo(up.x), silu_f(a[1]) * bfhi(up.x)); o.y = pk2(silu_f(a[2]) * bflo(up.y), silu_f(a[3]) * bfhi(up.y));
            o.z = pk2(silu_f(a[4]) * bflo(up.z), silu_f(a[5]) * bfhi(up.z)); o.w = pk2(silu_f(a[6]) * bflo(up.w), silu_f(a[7]) * bfhi(up.w));
            *(u32x4*)(ACT + (size_t)(row0 + r) * DFF + c0) = o;
            p0 = p1; p1 = p2;
        }
    }
}

DI int kfrag_off(int t, int d) { return (t >> 6) * 8192 + ((((t >> 4) & 3) * 4 + (d >> 5)) * 64 + ((d >> 3) & 3) * 16 + (t & 15)) * 8 + (d & 7); }
DI int vfrag_off(int t, int d) { const int ck = t & 63; return (t >> 6) * 8192 + (((d >> 4) * 2 + (ck >> 5)) * 64 + ((ck >> 2) & 3) * 16 + (d & 15)) * 8 + ((ck >> 4) & 1) * 4 + (ck & 3); }
DI void rope8(const u32x4 a, const u32x4 bq, const float* cs, const float* sn, float scale, u32x4& o1, u32x4& o2) {
    const f32x4 c0 = *(const f32x4*)cs, c1 = *(const f32x4*)(cs + 4), s0 = *(const f32x4*)sn, s1 = *(const f32x4*)(sn + 4);
    const float x1[8] = {bflo(a.x), bfhi(a.x), bflo(a.y), bfhi(a.y), bflo(a.z), bfhi(a.z), bflo(a.w), bfhi(a.w)};
    const float x2[8] = {bflo(bq.x), bfhi(bq.x), bflo(bq.y), bfhi(bq.y), bflo(bq.z), bfhi(bq.z), bflo(bq.w), bfhi(bq.w)};
    const float c[8] = {c0.x, c0.y, c0.z, c0.w, c1.x, c1.y, c1.z, c1.w}, s[8] = {s0.x, s0.y, s0.z, s0.w, s1.x, s1.y, s1.z, s1.w};
    float y1[8], y2[8];
#pragma unroll
    for (int j = 0; j < 8; ++j) { y1[j] = (x1[j] * c[j] - x2[j] * s[j]) * scale; y2[j] = (x2[j] * c[j] + x1[j] * s[j]) * scale; }
    o1.x = pk2(y1[0], y1[1]); o1.y = pk2(y1[2], y1[3]); o1.z = pk2(y1[4], y1[5]); o1.w = pk2(y1[6], y1[7]);
    o2.x = pk2(y2[0], y2[1]); o2.y = pk2(y2[2], y2[3]); o2.z = pk2(y2[4], y2[5]); o2.w = pk2(y2[6], y2[7]);
}
DI void rope8v(const u32x4 a, const u32x4 bq, const f32x4 c0, const f32x4 c1, const f32x4 s0, const f32x4 s1, float scale, u32x4& o1, u32x4& o2) {
    const float x1[8] = {bflo(a.x), bfhi(a.x), bflo(a.y), bfhi(a.y), bflo(a.z), bfhi(a.z), bflo(a.w), bfhi(a.w)};
    const float x2[8] = {bflo(bq.x), bfhi(bq.x), bflo(bq.y), bfhi(bq.y), bflo(bq.z), bfhi(bq.z), bflo(bq.w), bfhi(bq.w)};
    const float c[8] = {c0.x, c0.y, c0.z, c0.w, c1.x, c1.y, c1.z, c1.w}, s[8] = {s0.x, s0.y, s0.z, s0.w, s1.x, s1.y, s1.z, s1.w};
    float y1[8], y2[8];
#pragma unroll
    for (int j = 0; j < 8; ++j) { y1[j] = (x1[j] * c[j] - x2[j] * s[j]) * scale; y2[j] = (x2[j] * c[j] + x1[j] * s[j]) * scale; }
    o1.x = pk2(y1[0], y1[1]); o1.y = pk2(y1[2], y1[3]); o1.z = pk2(y1[4], y1[5]); o1.w = pk2(y1[6], y1[7]);
    o2.x = pk2(y2[0], y2[1]); o2.y = pk2(y2[2], y2[3]); o2.z = pk2(y2[4], y2[5]); o2.w = pk2(y2[6], y2[7]);
}
DI void nsa_rope(LAS unsigned char* ldsw  , int gw, int ngw, int lane, const bf16* PROJ, const float* SMALL, const float* ROPE, unsigned char* scr) {
    bf16* QR = (bf16*)(scr + SN_QR); bf16* KC = (bf16*)(scr + SN_KC); bf16* VC = (bf16*)(scr + SN_VC);
    bf16* KS = (bf16*)(scr + SN_KS); bf16* VS = (bf16*)(scr + SN_VS); bf16* KW = (bf16*)(scr + SN_KW); bf16* VW = (bf16*)(scr + SN_VW);
    float* GATE = (float*)(scr + SN_GATE);
    const float* COSF = ROPE; const float* SINF = ROPE + (size_t)SEQ * 64;
    if (gw == 0) { u32x4* z = (u32x4*)(VC + (size_t)16 * SEQ * 128); u32x4 zz = {0u, 0u, 0u, 0u}; asm volatile("" : "+v"(zz)); for (int i = lane; i < 512; i += 64) z[i] = zz; }
    for (int item = gw; item < 2048; item += ngw) {
        const int tg = item >> 2, g = item & 3, row0 = tg * 32, b = row0 >> 12, t0 = row0 & (SEQ - 1); const size_t bg = (size_t)(b * 4 + g);
        const bf16* pr0 = PROJ + (size_t)row0 * LDP_NSA;
#pragma unroll 1
        for (int hb = 0; hb < 2; ++hb) {
            u32x4 xa[2][7], xb[2][7]; f32x4 cs[2][2], sn[2][2];
#pragma unroll
            for (int u = 0; u < 2; ++u) { const int pidx = (hb * 2 + u) * 64 + lane, dg = pidx & 7, tt = pidx >> 3, t = t0 + tt;
                const bf16* p = pr0 + (size_t)tt * LDP_NSA + 8 * dg;
                cs[u][0] = *(const f32x4*)(COSF + t * 64 + 8 * dg); cs[u][1] = *(const f32x4*)(COSF + t * 64 + 8 * dg + 4); sn[u][0] = *(const f32x4*)(SINF + t * 64 + 8 * dg); sn[u][1] = *(const f32x4*)(SINF + t * 64 + 8 * dg + 4);
#pragma unroll
                for (int s = 0; s < 7; ++s) { const int c0 = s < 4 ? (4 * g + s) * 128 : (2048 + (s - 4) * 1024 + g * 128); xa[u][s] = *(const u32x4*)(p + c0); xb[u][s] = *(const u32x4*)(p + c0 + 64); } }
#pragma unroll
            for (int u = 0; u < 2; ++u) { const int pidx = (hb * 2 + u) * 64 + lane, dg = pidx & 7, tt = pidx >> 3, t = t0 + tt;
#pragma unroll
                for (int s = 0; s < 7; ++s) { u32x4 o1, o2;
                    rope8v(xa[u][s], xb[u][s], cs[u][0], cs[u][1], sn[u][0], sn[u][1], s < 4 ? 0.12751743074602565f : 1.f, o1, o2);
                    if (s < 4) { bf16* d = QR + ((bg * SEQ + t) * 4 + s) * 128 + 8 * dg; *(u32x4*)d = o1; *(u32x4*)(d + 64) = o2; }
                    else if (s == 4) { bf16* d = KC + (bg * SEQ + t) * 128 + 8 * dg; *(u32x4*)d = o1; *(u32x4*)(d + 64) = o2; }
                    else { bf16* d = (s == 5 ? KS : KW) + bg * (SEQ * 128); *(u32x4*)(d + kfrag_off(t, 8 * dg)) = o1; *(u32x4*)(d + kfrag_off(t, 64 + 8 * dg)) = o2; } } }
        }
        {
            LAS bf16* TS = (LAS bf16*)ldsw; LAS bf16* TW = TS + 32 * 136;
            u32x4 vc[8], vs[8], vw[8]; float gt[24];
#pragma unroll
            for (int i = 0; i < 8; ++i) { const int idx = i * 64 + lane, ch = idx & 15, tt = idx >> 4; const bf16* src = pr0 + (size_t)tt * LDP_NSA + g * 128 + 8 * ch;
                vc[i] = *(const u32x4*)(src + 2560); vs[i] = *(const u32x4*)(src + 3584); vw[i] = *(const u32x4*)(src + 4608); }
            if (g == 0) {
#pragma unroll
                for (int i = 0; i < 24; ++i) gt[i] = SMALL[(size_t)row0 * 48 + i * 64 + lane]; }
#pragma unroll
            for (int i = 0; i < 8; ++i) { const int idx = i * 64 + lane, ch = idx & 15, tt = idx >> 4;
                *(u32x4*)(VC + (bg * SEQ + t0 + tt) * 128 + 8 * ch) = vc[i]; *(LAS u32x4*)(TS + tt * 136 + 8 * ch) = vs[i]; *(LAS u32x4*)(TW + tt * 136 + 8 * ch) = vw[i]; }
            if (g == 0) {
#pragma unroll
                for (int i = 0; i < 24; ++i) GATE[(size_t)row0 * 48 + i * 64 + lane] = sigmoid_f(gt[i]); }
            asm volatile("s_waitcnt lgkmcnt(0)" ::: "memory");
#pragma unroll 2
            for (int i = 0; i < 8; ++i) { const int q = i >> 1, d = (i & 1) * 64 + lane;
                bf16 es[8], ew[8];
#pragma unroll
                for (int j = 0; j < 8; ++j) { const int tt = 4 * q + 16 * (j >> 2) + (j & 3); es[j] = TS[tt * 136 + d]; ew[j] = TW[tt * 136 + d]; }
                u32x4 a, c; a.x = es[0] | ((unsigned)es[1] << 16); a.y = es[2] | ((unsigned)es[3] << 16); a.z = es[4] | ((unsigned)es[5] << 16); a.w = es[6] | ((unsigned)es[7] << 16);
                c.x = ew[0] | ((unsigned)ew[1] << 16); c.y = ew[2] | ((unsigned)ew[3] << 16); c.z = ew[4] | ((unsigned)ew[5] << 16); c.w = ew[6] | ((unsigned)ew[7] << 16);
                const int off = vfrag_off(t0 + 4 * q, d);
                *(u32x4*)(VS + bg * (SEQ * 128) + off) = a; *(u32x4*)(VW + bg * (SEQ * 128) + off) = c; }
            asm volatile("s_waitcnt lgkmcnt(0)" ::: "memory");
        }
    }
}

DI void nsa_cmp(LAS unsigned char* lds, int tid, int lane, int wave, int G, int blk, const unsigned char* scr, bf16* YC, unsigned long long* SELM) {
    const bf16* QR = (const bf16*)(scr + SN_QR); const bf16* KCF = (const bf16*)(scr + SN_KCF); const bf16* VCF = (const bf16*)(scr + SN_VCF); const float* GATE = (const float*)(scr + SN_GATE);
    LAS bf16* LK = (LAS bf16*)lds; LAS bf16* LV = (LAS bf16*)(lds + 65536); LAS float* SCL = (LAS float*)(lds + 131072);
    const int fr = lane & 15, fq = lane >> 4;
    for (int ui = (G == 256) ? 0 : blk; ui < ((G == 256) ? 4 : 1024); ui += (G == 256) ? 1 : G) {
        int unit = ui;
        if (G == 256) { const int j = blk & 15; const int qq = ui == 0 ? j : (ui == 1 ? 31 - j : (ui == 2 ? 32 + j : 63 - j)); unit = ((blk >> 4) << 6) | qq; }
        const int bg = unit >> 6, qt = unit & 63, t0 = qt * 64, b = bg >> 2, g = bg & 3;
        const int cmax = (t0 + 32) >> 4; const int nblk = (cmax >> 6) + 1 < 4 ? (cmax >> 6) + 1 : 4;
        {
            const u32x4* kg = (const u32x4*)(KCF + (size_t)bg * 32768); const u32x4* vg = (const u32x4*)(VCF + (size_t)bg * 32768);
            for (int j = 0; j < nblk * 2; ++j) { const int pc = j * 8 + wave;
                __builtin_amdgcn_global_load_lds((const unsigned*)(kg + pc * 64 + lane), (LAS unsigned*)(lds + pc * 1024), 16, 0, 0);
                __builtin_amdgcn_global_load_lds((const unsigned*)(vg + pc * 64 + lane), (LAS unsigned*)(lds + 65536 + pc * 1024), 16, 0, 0); }
        }
        const float gate0 = GATE[((size_t)b * SEQ + t0 + 8 * wave + (fr >> 2)) * 48 + g * 4 + (fr & 3)], gate1 = GATE[((size_t)b * SEQ + t0 + 8 * wave + 4 + (fr >> 2)) * 48 + g * 4 + (fr & 3)];
        asm volatile("s_waitcnt vmcnt(0)" ::: "memory");
        __syncthreads();
#pragma unroll 1
        for (int nt = 0; nt < 2; ++nt) {
            const int tokbase = t0 + 8 * wave + 4 * nt;
            const bf16* qp = QR + (((size_t)bg * SEQ + tokbase) * 4 + fr) * 128 + 8 * fq;
            bf16x8 qf[4];
#pragma unroll
            for (int kk = 0; kk < 4; ++kk) qf[kk] = *(const bf16x8*)(qp + 32 * kk);
            f32x4 st[16];
#pragma unroll
            for (int b4 = 0; b4 < 4; ++b4) {
                if (b4 < nblk) {
                    bf16x8 kf[16];
#pragma unroll
                    for (int i = 0; i < 16; ++i) kf[i] = *(const LAS bf16x8*)(LK + b4 * 8192 + (i * 64 + lane) * 8);
                    f32x4 a4[4];
#pragma unroll
                    for (int t4 = 0; t4 < 4; ++t4) a4[t4] = (f32x4){0.f, 0.f, 0.f, 0.f};
#pragma unroll
                    for (int kk = 0; kk < 4; ++kk)
#pragma unroll
                        for (int t4 = 0; t4 < 4; ++t4) a4[t4] = MFMA16(kf[t4 * 4 + kk], qf[kk], a4[t4]);
                    __builtin_amdgcn_sched_group_barrier(0x100, 16, 0);
                    __builtin_amdgcn_sched_group_barrier(0x008, 16, 0);
#pragma unroll
                    for (int t4 = 0; t4 < 4; ++t4) st[4 * b4 + t4] = a4[t4];
                } else {
#pragma unroll
                    for (int t4 = 0; t4 < 4; ++t4) st[4 * b4 + t4] = (f32x4){0.f, 0.f, 0.f, 0.f};
                }
            }
            const int t = tokbase + (fr >> 2);
            float m = NEGF;
#pragma unroll
            for (int tile = 0; tile < 16; ++tile)
#pragma unroll
                for (int r = 0; r < 4; ++r) { const int c = 16 * tile + 4 * fq + r; const bool valid = (tile < nblk * 4) && (16 * c + 31 <= t); const float s = valid ? st[tile][r] : NEGF; st[tile][r] = s; m = fmaxf(m, s); }
            m = quad_max(m);
            float l = 0.f;
#pragma unroll
            for (int tile = 0; tile < 16; ++tile)
#pragma unroll
                for (int r = 0; r < 4; ++r) { const float p = (st[tile][r] > -1e29f) ? __builtin_amdgcn_exp2f(st[tile][r] - m) : 0.f; st[tile][r] = p; l += p; }
            l = quad_sum(l);
            const float inv = l > 0.f ? 1.f / l : 0.f;
#pragma unroll
            for (int tile = 0; tile < 16; ++tile) st[tile] = st[tile] * inv;
#pragma unroll
            for (int tile = 0; tile < 16; ++tile) {
                const float prevtile3 = tile > 0 ? st[tile > 0 ? tile - 1 : 0][3] : 0.f;
                const float send = (fq == 3) ? prevtile3 : st[tile][3];
                const float prev = __shfl(send, (lane + 48) & 63);
                float sc = prev + 2.f * (st[tile][0] + st[tile][1] + st[tile][2]) + st[tile][3];
                sc += __shfl_xor(sc, 1); sc += __shfl_xor(sc, 2);
                if ((lane & 3) == 0) SCL[(wave * 8 + 4 * nt + (fr >> 2)) * 64 + 4 * tile + fq] = sc;
            }
            f32x4 ot[8];
#pragma unroll
            for (int dt = 0; dt < 8; ++dt) ot[dt] = (f32x4){0.f, 0.f, 0.f, 0.f};
#pragma unroll
            for (int b4 = 0; b4 < 4; ++b4) {
                if (b4 < nblk) {
                    bf16x8 vf[16];
#pragma unroll
                    for (int i = 0; i < 16; ++i) vf[i] = *(const LAS bf16x8*)(LV + b4 * 8192 + (i * 64 + lane) * 8);
                    const bf16x8 pb0 = pack8(st[4 * b4], st[4 * b4 + 1]), pb1 = pack8(st[4 * b4 + 2], st[4 * b4 + 3]);
#pragma unroll
                    for (int dt = 0; dt < 8; ++dt) ot[dt] = MFMA16(vf[dt * 2], pb0, ot[dt]);
#pragma unroll
                    for (int dt = 0; dt < 8; ++dt) ot[dt] = MFMA16(vf[dt * 2 + 1], pb1, ot[dt]);
                    __builtin_amdgcn_sched_group_barrier(0x100, 16, 0);
                    __builtin_amdgcn_sched_group_barrier(0x008, 16, 0);
                }
            }
            const int head = fr & 3; const size_t row = (size_t)b * SEQ + t;
            const float gate = nt ? gate1 : gate0;
            bf16* yo = YC + row * DM + (g * 4 + head) * 128 + 4 * fq;
#pragma unroll
            for (int dt = 0; dt < 8; ++dt) { const f32x4 y = ot[dt] * gate; u32x2 w; w.x = pk2(y.x, y.y); w.y = pk2(y.z, y.w); *(u32x2*)(yo + 16 * dt) = w; }
        }
        asm volatile("s_waitcnt lgkmcnt(0)" ::: "memory");
        {
            unsigned key[8], th[8];
#pragma unroll
            for (int u = 0; u < 8; ++u) {
                const int t = t0 + 8 * wave + u, n = lane, cur = t >> 6;
                const bool valid = (n * 64 <= t), forced = (n == 0) || (n == cur) || (n + 1 == cur);
                const float s = SCL[(wave * 8 + u) * 64 + lane] + (forced ? 1000.f : 0.f);
                key[u] = valid ? (__float_as_uint(fmaxf(s, 0.f)) + 1u) : 0u; th[u] = 0u;
            }
#pragma unroll 1
            for (int bit = 30; bit >= 0; --bit) {
#pragma unroll
                for (int u = 0; u < 8; ++u) { const unsigned c = th[u] | (1u << bit); th[u] = __popcll(__ballot(key[u] >= c)) >= 16 ? c : th[u]; }
            }
#pragma unroll
            for (int u = 0; u < 8; ++u) {
                const unsigned long long gt = __ballot(key[u] > th[u]), eq = __ballot(key[u] == th[u] && key[u] != 0u);
                const int need = 16 - __popcll(gt);
                const bool sel = (key[u] > th[u]) || (key[u] == th[u] && key[u] != 0u && __popcll(eq & ((1ull << lane) - 1ull)) < need);
                const unsigned long long mask = __ballot(sel);
                if (lane == 0) SELM[(size_t)bg * SEQ + t0 + 8 * wave + u] = mask;
            }
        }
        __syncthreads();
    }
}

DI void qk_tiles(const LAS bf16x8* Kb, int lane, const bf16x8 (&qf)[2][4], f32x4 (&st)[2][4]) {
    bf16x8 a0 = Kb[lane], a1 = Kb[64 + lane], b0 = Kb[128 + lane], b1 = Kb[192 + lane];
    __builtin_amdgcn_sched_group_barrier(0x100, 4, 0);
#pragma unroll
    for (int kt = 0; kt < 4; ++kt) {
        f32x4 acc0 = {0.f, 0.f, 0.f, 0.f}, acc1 = {0.f, 0.f, 0.f, 0.f};
#pragma unroll
        for (int kp = 0; kp < 2; ++kp) {
            const int s2 = kt * 2 + kp + 2;
            bf16x8 c0 = b0, c1 = b1;
            if (s2 < 8) { c0 = Kb[(s2 * 2) * 64 + lane]; c1 = Kb[(s2 * 2 + 1) * 64 + lane]; }
            acc0 = MFMA16(a0, qf[0][2 * kp], acc0); acc1 = MFMA16(a0, qf[1][2 * kp], acc1);
            acc0 = MFMA16(a1, qf[0][2 * kp + 1], acc0); acc1 = MFMA16(a1, qf[1][2 * kp + 1], acc1);
            if (s2 < 8) __builtin_amdgcn_sched_group_barrier(0x100, 2, 0);
            __builtin_amdgcn_sched_group_barrier(0x008, 4, 0);
            a0 = b0; a1 = b1; b0 = c0; b1 = c1;
        }
        st[0][kt] = acc0; st[1][kt] = acc1;
    }
}
template <int MODE>
DI void softmax_pv(const LAS bf16x8* Vb, int lane, int wave, int fr, int fq, int kb, int qt, int t0, unsigned long long sm0, unsigned long long sm1,
                   f32x4 (&st)[2][4], float (&m)[2], float (&l)[2], f32x4 (&ot)[2][8]) {
    const bool edge = MODE ? ((kb == qt) || (kb + 8 == qt)) : (kb == qt);
    constexpr float RESC_THR = 8.f;
    bf16x8 pb[2][2];
#pragma unroll
    for (int nt = 0; nt < 2; ++nt) {
        const int t = t0 + 8 * wave + 4 * nt + (fr >> 2);
        const bool colsel = MODE ? true : (((nt ? sm1 : sm0) >> kb) & 1ull) != 0ull;
        if (edge) {
#pragma unroll
            for (int kt = 0; kt < 4; ++kt)
#pragma unroll
                for (int r = 0; r < 4; ++r) { const int key = 64 * kb + 16 * kt + 4 * fq + r; const bool vis = key <= t && (MODE == 0 || key > t - 512); st[nt][kt][r] = vis ? st[nt][kt][r] : NEGF; }
        }
        float bm = quad_max(max16f(st[nt]));
        if (MODE == 0) bm = colsel ? bm : NEGF;
        if (__any(bm - m[nt] > RESC_THR)) {
            const float mnew = max2f(m[nt], bm);
            const float al = __builtin_amdgcn_exp2f(max2f(m[nt], -1e20f) - max2f(mnew, -1e20f));
            l[nt] *= al; m[nt] = mnew;
#pragma unroll
            for (int dt = 0; dt < 8; ++dt) scale_inplace(ot[nt][dt], al);
        }
        const float mexp = (MODE == 0 && !colsel) ? 1e30f : max2f(m[nt], -1e20f);
        const f32x2 mexp2 = {mexp, mexp};
#pragma unroll
        for (int kt = 0; kt < 4; ++kt) { const f32x2 dl = sub_pk((f32x2){st[nt][kt][0], st[nt][kt][1]}, mexp2), dh = sub_pk((f32x2){st[nt][kt][2], st[nt][kt][3]}, mexp2); st[nt][kt] = (f32x4){__builtin_amdgcn_exp2f(dl[0]), __builtin_amdgcn_exp2f(dl[1]), __builtin_amdgcn_exp2f(dh[0]), __builtin_amdgcn_exp2f(dh[1])}; }
        const f32x4 s4 = (st[nt][0] + st[nt][1]) + (st[nt][2] + st[nt][3]);
        l[nt] += quad_sum((s4[0] + s4[1]) + (s4[2] + s4[3]));
        pb[nt][0] = pack8(st[nt][0], st[nt][1]); pb[nt][1] = pack8(st[nt][2], st[nt][3]);
    }
    {
        bf16x8 v0 = Vb[lane], v1 = Vb[64 + lane], w0 = Vb[128 + lane], w1 = Vb[192 + lane];
        __builtin_amdgcn_sched_group_barrier(0x100, 4, 0);
#pragma unroll
        for (int dt = 0; dt < 8; ++dt) {
            bf16x8 x0 = w0, x1 = w1;
            if (dt < 6) { x0 = Vb[((dt + 2) * 2 + 0) * 64 + lane]; x1 = Vb[((dt + 2) * 2 + 1) * 64 + lane]; }
#pragma unroll
            for (int nt = 0; nt < 2; ++nt) { f32x4 o = ot[nt][dt]; o = MFMA16(v0, pb[nt][0], o); o = MFMA16(v1, pb[nt][1], o); ot[nt][dt] = o; }
            if (dt < 6) __builtin_amdgcn_sched_group_barrier(0x100, 2, 0);
            __builtin_amdgcn_sched_group_barrier(0x008, 4, 0);
            v0 = w0; v1 = w1; w0 = x0; w1 = x1;
        }
    }
}
DI void pv_only(const LAS bf16x8* Vb, int lane, f32x4 (&st)[2][4], f32x4 (&ot)[2][8]) {
    bf16x8 pb[2][2];
#pragma unroll
    for (int nt = 0; nt < 2; ++nt) { pb[nt][0] = pack8(st[nt][0], st[nt][1]); pb[nt][1] = pack8(st[nt][2], st[nt][3]); }
#pragma unroll
    for (int dt = 0; dt < 8; ++dt) { const bf16x8 v0 = Vb[(dt * 2 + 0) * 64 + lane], v1 = Vb[(dt * 2 + 1) * 64 + lane];
#pragma unroll
        for (int nt = 0; nt < 2; ++nt) { f32x4 o = ot[nt][dt]; o = MFMA16(v0, pb[nt][0], o); o = MFMA16(v1, pb[nt][1], o); ot[nt][dt] = o; } }
}
template <int MODE>
DI void softmax_only(int lane, int wave, int fr, int fq, int kb, int qt, int t0, unsigned long long sm0, unsigned long long sm1, f32x4 (&st)[2][4], float (&m)[2], float (&l)[2], f32x4 (&ot)[2][8]) {
    constexpr float RESC_THR = 8.f;
#pragma unroll
    for (int nt = 0; nt < 2; ++nt) {
        const bool colsel = MODE ? true : (((nt ? sm1 : sm0) >> kb) & 1ull) != 0ull;
        float bm = quad_max(max16f(st[nt]));
        if (MODE == 0) bm = colsel ? bm : NEGF;
        if (__any(bm - m[nt] > RESC_THR)) { const float mnew = fmaxf(m[nt], bm); const float al = __builtin_amdgcn_exp2f(fmaxf(m[nt], -1e20f) - fmaxf(mnew, -1e20f)); l[nt] *= al; m[nt] = mnew;
#pragma unroll
            for (int dt = 0; dt < 8; ++dt) ot[nt][dt] = ot[nt][dt] * al; }
        const float mexp = (MODE == 0 && !colsel) ? 1e30f : fmaxf(m[nt], -1e20f);
#pragma unroll
        for (int kt = 0; kt < 4; ++kt) { const f32x4 d = st[nt][kt] - mexp; st[nt][kt] = (f32x4){__builtin_amdgcn_exp2f(d[0]), __builtin_amdgcn_exp2f(d[1]), __builtin_amdgcn_exp2f(d[2]), __builtin_amdgcn_exp2f(d[3])}; }
        const f32x4 s4 = (st[nt][0] + st[nt][1]) + (st[nt][2] + st[nt][3]);
        l[nt] += quad_sum((s4[0] + s4[1]) + (s4[2] + s4[3]));
        const bf16x8 p0 = pack8(st[nt][0], st[nt][1]), p1 = pack8(st[nt][2], st[nt][3]);
        ot[nt][0][0] += __builtin_bit_cast(f32x4, p0)[0] * 1e-30f + __builtin_bit_cast(f32x4, p1)[1] * 1e-30f;
    }
}
template <int MODE, int SLOT, int DRY>
DI void block_step(LAS unsigned char* lds, int lane, int wave, int fr, int fq, const u32x4* kg, const u32x4* vg, int i, int kb0, int nkb, int qt, int t0,
                   const bf16x8 (&qf)[2][4], unsigned long long sm0, unsigned long long sm1, unsigned long long wneed, float (&m)[2], float (&l)[2], f32x4 (&ot)[2][8]) {
    asm volatile("s_waitcnt vmcnt(0)" ::: "memory");
    __syncthreads();
    if (i + 1 < nkb) {
#pragma unroll
        for (int j = 0; j < 2; ++j) { const int pc = wave * 2 + j;
            __builtin_amdgcn_global_load_lds((const unsigned*)(kg + (i + 1) * 1024 + pc * 64 + lane), (LAS unsigned*)(lds + (1 - SLOT) * 32768 + pc * 1024), 16, 0, 0);
            __builtin_amdgcn_global_load_lds((const unsigned*)(vg + (i + 1) * 1024 + pc * 64 + lane), (LAS unsigned*)(lds + (1 - SLOT) * 32768 + 16384 + pc * 1024), 16, 0, 0); } }
    const int kb = kb0 + i;
    if (MODE == 0 && !((wneed >> kb) & 1ull)) return;
    f32x4 st[2][4];
    if (DRY == 3) return;
    if (DRY == 2) {
#pragma unroll
        for (int nt = 0; nt < 2; ++nt)
#pragma unroll
            for (int kt = 0; kt < 4; ++kt) st[nt][kt] = (f32x4){0.f, 0.25f, 0.5f, 0.75f} + (float)(lane & 7);
        softmax_only<MODE>(lane, wave, fr, fq, kb, qt, t0, sm0, sm1, st, m, l, ot);
        return; }
    qk_tiles((const LAS bf16x8*)(lds + SLOT * 32768), lane, qf, st);
    if (DRY == 1) { pv_only((const LAS bf16x8*)(lds + SLOT * 32768 + 16384), lane, st, ot); return; }
    softmax_pv<MODE>((const LAS bf16x8*)(lds + SLOT * 32768 + 16384), lane, wave, fr, fq, kb, qt, t0, sm0, sm1, st, m, l, ot);
}
template <int MODE, int DRY>
DI void block_pass(LAS unsigned char* lds, int tid, int lane, int wave, int fr, int fq, const u32x4* kg, const u32x4* vg, int kb0, int nkb, int qt, int t0,
                   const bf16x8 (&qf)[2][4], unsigned long long sm0, unsigned long long sm1, unsigned long long wneed, float (&m)[2], float (&l)[2], f32x4 (&ot)[2][8]) {
#pragma unroll
    for (int j = 0; j < 2; ++j) { const int pc = wave * 2 + j;
        __builtin_amdgcn_global_load_lds((const unsigned*)(kg + pc * 64 + lane), (LAS unsigned*)(lds + pc * 1024), 16, 0, 0);
        __builtin_amdgcn_global_load_lds((const unsigned*)(vg + pc * 64 + lane), (LAS unsigned*)(lds + 16384 + pc * 1024), 16, 0, 0); }
    for (int i = 0; i < nkb; i += 2) {
        block_step<MODE, 0, DRY>(lds, lane, wave, fr, fq, kg, vg, i, kb0, nkb, qt, t0, qf, sm0, sm1, wneed, m, l, ot);
        if (i + 1 < nkb) block_step<MODE, 1, DRY>(lds, lane, wave, fr, fq, kg, vg, i + 1, kb0, nkb, qt, t0, qf, sm0, sm1, wneed, m, l, ot);
    }
}
#ifndef DRYMODE
#define DRYMODE 0
#endif
template <int DRY>
DI void nsa_selwin(LAS unsigned char* lds, int tid, int lane, int wave, int G, int blk, const unsigned char* scr, const bf16* YC, bf16* Y) {
    const bf16* QR = (const bf16*)(scr + SN_QR); const float* GATE = (const float*)(scr + SN_GATE);
    const bf16* KS = (const bf16*)(scr + SN_KS); const bf16* VS = (const bf16*)(scr + SN_VS); const bf16* KW = (const bf16*)(scr + SN_KW); const bf16* VW = (const bf16*)(scr + SN_VW);
    const unsigned long long* SELM = (const unsigned long long*)(scr + SN_SELM);
    LAS u32x2* STASH = (LAS u32x2*)(lds + 65536) + wave * 1024;
    const int fr = lane & 15, fq = lane >> 4;
    for (int pu = 2 * blk; pu < 1024; pu += (pu & 1) ? 2 * G - 1 : 1) {
        int pi = pu >> 1; const int half = pu & 1;
        if (G == 256) { const int rr = pi >> 8, bx = pi & 255; pi = ((2 * (bx & 7) + rr) << 5) | (bx >> 3); }
        const int bg = pi >> 5, jj = pi & 31, qt = half ? 63 - jj : jj;
        const int t0 = qt * 64, b = bg >> 2, g = bg & 3;
        bf16x8 qf[2][4];
#pragma unroll
        for (int nt = 0; nt < 2; ++nt)
#pragma unroll
            for (int kk = 0; kk < 4; ++kk) qf[nt][kk] = *(const bf16x8*)(QR + (((size_t)bg * SEQ + t0 + 8 * wave + 4 * nt) * 4 + fr) * 128 + 32 * kk + 8 * fq);
        const unsigned long long sm0 = SELM[(size_t)bg * SEQ + t0 + 8 * wave + (fr >> 2)], sm1 = SELM[(size_t)bg * SEQ + t0 + 8 * wave + 4 + (fr >> 2)];
        unsigned lo = (unsigned)(sm0 | sm1), hi = (unsigned)((sm0 | sm1) >> 32);
#pragma unroll
        for (int o = 1; o < 64; o <<= 1) { lo |= (unsigned)__shfl_xor((int)lo, o); hi |= (unsigned)__shfl_xor((int)hi, o); }
        const unsigned long long wneed = ((unsigned long long)(unsigned)__builtin_amdgcn_readfirstlane((int)hi) << 32) | (unsigned)__builtin_amdgcn_readfirstlane((int)lo);
        float m[2] = {NEGF, NEGF}, l[2] = {0.f, 0.f};
        f32x4 ot[2][8];
#pragma unroll
        for (int nt = 0; nt < 2; ++nt)
#pragma unroll
            for (int dt = 0; dt < 8; ++dt) ot[nt][dt] = (f32x4){0.f, 0.f, 0.f, 0.f};
        block_pass<0, DRY>(lds, tid, lane, wave, fr, fq, (const u32x4*)(KS + (size_t)bg * 64 * 8192), (const u32x4*)(VS + (size_t)bg * 64 * 8192), 0, qt + 1, qt, t0, qf, sm0, sm1, wneed, m, l, ot);
#pragma unroll
        for (int nt = 0; nt < 2; ++nt) {
            const int t = t0 + 8 * wave + 4 * nt + (fr >> 2), head = fr & 3; const size_t row = (size_t)b * SEQ + t;
            const float sc = GATE[row * 48 + 16 + g * 4 + head] / l[nt];
#pragma unroll
            for (int dt = 0; dt < 8; ++dt) { const f32x4 y = ot[nt][dt] * sc; u32x2 w; w.x = pk2(y.x, y.y); w.y = pk2(y.z, y.w); STASH[(nt * 8 + dt) * 64 + lane] = w; ot[nt][dt] = (f32x4){0.f, 0.f, 0.f, 0.f}; }
            m[nt] = NEGF; l[nt] = 0.f;
        }
        __syncthreads();
        const int kb0 = qt >= 8 ? qt - 8 : 0;
        block_pass<1, DRY>(lds, tid, lane, wave, fr, fq, (const u32x4*)(KW + ((size_t)bg * 64 + kb0) * 8192), (const u32x4*)(VW + ((size_t)bg * 64 + kb0) * 8192), kb0, qt - kb0 + 1, qt, t0, qf, 0ull, 0ull, 0ull, m, l, ot);
#pragma unroll
        for (int nt = 0; nt < 2; ++nt) {
            const int t = t0 + 8 * wave + 4 * nt + (fr >> 2), head = fr & 3; const size_t row = (size_t)b * SEQ + t;
            const float sc = GATE[row * 48 + 32 + g * 4 + head] / l[nt];
            const size_t off = row * DM + (g * 4 + head) * 128 + 4 * fq;
#pragma unroll
            for (int dt = 0; dt < 8; ++dt) { const u32x2 c = *(const u32x2*)(YC + off + 16 * dt), s2 = STASH[(nt * 8 + dt) * 64 + lane];
                const f32x4 y = ot[nt][dt] * sc + (f32x4){bflo(c.x) + bflo(s2.x), bfhi(c.x) + bfhi(s2.x), bflo(c.y) + bflo(s2.y), bfhi(c.y) + bfhi(s2.y)};
                u32x2 w; w.x = pk2(y.x, y.y); w.y = pk2(y.z, y.w); *(u32x2*)(Y + off + 16 * dt) = w; }
        }
        __syncthreads();
    }
}

#ifndef MK_MULTI
#define MK_MULTI 0
#endif
constexpr int PH_PER_LAYER = 13, NPHASE = 1 + 4 * PH_PER_LAYER;

template <class Epi> DI void run_gemm(LAS unsigned char* lds, const bf16* A, int lda, const bf16* Bt, int ldb, int M, int N, int K, const Epi& E, int G, int c, int tid) {
#ifdef GEMM_STAGGER
    if (N >= 4096) { for (int i = 0; i < (c & 3); ++i) __builtin_amdgcn_s_sleep(GEMM_STAGGER); }
#endif
    pg8::Gemm g{A, Bt, M, N, K, lda, ldb}; pg8::StaticOrder S; S.init(M, N, G, c);
    #ifndef GEMM_ALIGN
#define GEMM_ALIGN true
#endif
#ifndef GEMM_SP2
#define GEMM_SP2 true
#endif
    pg8::gemm_phase<Epi, pg8::StaticOrder, GEMM_ALIGN, GEMM_SP2>(lds, g, S, E, tid);
}

__global__ void __launch_bounds__(NTHR, 2) fwd_kernel(Args a) {
    extern __shared__ __attribute__((aligned(16))) unsigned char lds_raw[];
    LAS unsigned char* lds = (LAS unsigned char*)lds_raw;
    const int tid0 = threadIdx.x;
    const int G = gridDim.x, blk0 = blockIdx.x;
#define LAUNDER int tid = tid0, blk = blk0; asm volatile("" : "+v"(tid), "+s"(blk)); const int lane = tid & 63, wave = __builtin_amdgcn_readfirstlane(tid >> 6), gw = blk * NWAVES + wave, ngw = G * NWAVES; (void)lane; (void)wave; (void)gw; (void)ngw;
    unsigned char* ws = a.ws;
    volatile LAS unsigned* MISC = (volatile LAS unsigned*)(lds + LDS_MISC);
    if (tid0 < 64) MISC[tid0] = 0u;
    __syncthreads();
    XcdBarrier bar; bar.bar = (unsigned*)(ws + WS_CTL) + CW_BAR; bar.x = 0; bar.st = nullptr;
    if (!MK_MULTI) {
        bar = xcd_barrier_post((unsigned*)(ws + WS_CTL) + CW_BAR, MISC + 8);
        if (tid0 == 0) { unsigned nloc, nx; xcd_barrier_complete(bar.bar, bar.x, nloc, nx); MISC[8] = nloc; MISC[9] = nx; }
        __syncthreads();
    }
    const int lo = a.ph_lo, hi = a.ph_hi;
#ifndef ONLY
#define ONLY -1
#endif
#define SEL(id) (ONLY < 0 || ONLY == (id))
#ifndef REPID
#define REPID -1
#endif
#ifndef REPID2
#define REPID2 -1
#endif
#ifndef REPPAIR
#define REPPAIR 1
#endif
#define NREP(id) ((REPID == (id) || REPID2 == (id)) ? 2 : 1)
#define PH(k) (lo <= (k) && (k) < hi)
#define END(k) do { if (!MK_MULTI && (k) + 1 < hi) xcd_barrier(bar); } while (0)

    unsigned char* scr = ws + WS_SCR;
    bf16* XN = (bf16*)(ws + WS_XN); bf16* MF = (bf16*)(ws + WS_MF); bf16* HB = (bf16*)(ws + WS_MF) + (size_t)MTOK * DM; float* H = a.out;
    bf16* Y = (bf16*)(scr + SC_Y);
    const float* nw = a.in[1]; float* RS = (float*)(ws + WS_RS);

    if (SEL(0) && PH(0)) { for (int rep_ = 0; rep_ < NREP(0); ++rep_) { LAUNDER p0_prologue(a, ws, lds, tid, lane, wave, G, blk); END(0); } }

#pragma unroll 1
    for (int l = 0; l < 4; ++l) {
        const int pb = 1 + l * PH_PER_LAYER, li = l >> 1;
        if ((l & 1) == 0) {
            bf16* PROJ = (bf16*)(scr + SC_PROJ);
            if (SEL(1) && PH(pb + 0)) { for (int rep_ = 0; rep_ < NREP(1); ++rep_) { LAUNDER const bf16* AIN = l == 0 ? XN : HB; pg8::EpiBf16<0> E{PROJ, LDP_AB, nullptr, RS}; run_gemm(lds, AIN, DM, (const bf16*)(ws + WS_WAB_IN) + (size_t)li * N_AB * DM, DM, MTOK, N_AB, DM, E, G, blk, tid); for (int qp = blk; qp < 256; qp += G) narrow_gemm<1>(lds, qp, tid, AIN, (const bf16*)(ws + WS_WAB_S) + (size_t)li * 16 * DM, (float*)(ws + WS_SMALL), RS); END(pb + 0); } }
            if (SEL(2) && PH(pb + 1)) { for (int rep_ = 0; rep_ < NREP(2); ++rep_) { LAUNDER gdn_prep(lds, tid, lane, wave, G, blk, PROJ, (const float*)(ws + WS_SMALL), a.in[4] + (size_t)li * 4 * 3072, a.in[5] + li * 8, a.in[6] + li * 8, scr + SC_GOPS, (float*)(scr + SC_GEG)); END(pb + 1); } }
            if (SEL(3) && PH(pb + 2)) { for (int rep_ = 0; rep_ < NREP(3); ++rep_) { LAUNDER gdn_scan(lds, tid, lane, wave, G, blk, scr + SC_GOPS, (const float*)(scr + SC_GEG), (bf16*)(scr + SC_GO)); if (G == 256 && blk >= 128 && rep_ == 0) { transpose_jobs(a, ws, (LAS float*)(lds + wave * 16640), lane, (blk - 128) * NWAVES + wave, 128 * NWAVES, 22 + l, 23 + l); transpose_jobs(a, ws, (LAS float*)(lds + wave * 16640), lane, (blk - 128) * NWAVES + wave, 128 * NWAVES, 26 + l, 27 + l); } END(pb + 2); } }
            if (SEL(4) && PH(pb + 3)) { for (int rep_ = 0; rep_ < NREP(4); ++rep_) { LAUNDER gdn_out(gw, ngw, lane, (const bf16*)(scr + SC_GO), PROJ, a.in[7] + li * 128, a.in[8] + (size_t)li * 3 * 1024, Y); END(pb + 3); } }
            if (SEL(5) && PH(pb + 4)) { for (int rep_ = 0; rep_ < NREP(5); ++rep_) { LAUNDER pg8::EpiBf16<0> E{MF, DM, nullptr}; run_gemm(lds, Y, DM, (const bf16*)(ws + WS_WAB_OUT) + (size_t)li * DM * DM, DM, MTOK, DM, DM, E, G, blk, tid); END(pb + 4); } }
        } else {
            bf16* PROJ = (bf16*)(scr + SC_PROJ);
            if (SEL(21) && PH(pb + 0)) { for (int rep_ = 0; rep_ < NREP(21); ++rep_) { LAUNDER pg8::EpiBf16<0> E{PROJ, LDP_NSA, nullptr, RS}; run_gemm(lds, HB, DM, (const bf16*)(ws + WS_WNSA_IN) + (size_t)li * N_NSA * DM, DM, MTOK, N_NSA, DM, E, G, blk, tid); for (int qp = blk; qp < 256; qp += G) narrow_gemm<3>(lds, qp, tid, HB, (const bf16*)(ws + WS_WNSA_S) + (size_t)li * 48 * DM, (float*)(ws + WS_SMALL), RS); END(pb + 0); } }
            if (SEL(22) && PH(pb + 1)) { for (int rep_ = 0; rep_ < NREP(22); ++rep_) { LAUNDER nsa_rope(lds + wave * 17408, gw, ngw, lane, PROJ, (const float*)(ws + WS_SMALL), (const float*)(ws + WS_ROPE), scr); END(pb + 1); } }
            if (SEL(23) && PH(pb + 2)) { for (int rep_ = 0; rep_ < NREP(23); ++rep_) { LAUNDER
                const int isv = blk >= 16 ? 1 : 0, c = blk < 32 ? (blk & 15) : -1;
                pg8::EpiBf16<1> E{(bf16*)(scr + (isv ? SN_HCV : SN_HCK)), 256, (const float*)(ws + WS_CBIAS) + (li * 2 + isv) * 256};
                run_gemm(lds, (const bf16*)(scr + (isv ? SN_VC : SN_KC)), 2048, (const bf16*)(ws + WS_WC1) + (size_t)(li * 2 + isv) * 256 * 4096, 4096, 4096, 256, 4096, E, 16, c, tid);
                if (G == 256 && blk >= 32 && rep_ == 0) { transpose_jobs(a, ws, (LAS float*)(lds + wave * 16640), lane, (blk - 32) * NWAVES + wave, 224 * NWAVES, 22 + l, 23 + l); transpose_jobs(a, ws, (LAS float*)(lds + wave * 16640), lane, (blk - 32) * NWAVES + wave, 224 * NWAVES, 26 + l, 27 + l); } END(pb + 2); } }
            if (SEL(24) && PH(pb + 3)) { for (int rep_ = 0; rep_ < NREP(24); ++rep_) { LAUNDER
                if (blk < 16) { pg8::EpiFrag<false> E{(bf16*)(scr + SN_KCF)}; run_gemm(lds, (const bf16*)(scr + SN_HCK), 256, (const bf16*)(ws + WS_WC2) + (size_t)(li * 2 + 0) * 256 * 256, 256, 4096, 256, 256, E, 16, blk, tid); }
                else if (blk < 32) { pg8::EpiFrag<true> E{(bf16*)(scr + SN_VCF)}; run_gemm(lds, (const bf16*)(scr + SN_HCV), 256, (const bf16*)(ws + WS_WC2) + (size_t)(li * 2 + 1) * 256 * 256, 256, 4096, 256, 256, E, 16, blk - 16, tid); }
                END(pb + 3); } }
            for (int rp_ = 0; rp_ < REPPAIR; ++rp_) {
            if (SEL(25) && PH(pb + 4)) { for (int rep_ = 0; rep_ < NREP(25); ++rep_) { LAUNDER nsa_cmp(lds, tid, lane, wave, G, blk, scr, (bf16*)(scr + SN_YF), (unsigned long long*)(scr + SN_SELM)); END(pb + 4); } }
            if (SEL(26) && PH(pb + 5)) { for (int rep_ = 0; rep_ < NREP(26); ++rep_) { LAUNDER { if (rep_ + 1 < NREP(26)) nsa_selwin<DRYMODE>(lds, tid, lane, wave, G, blk, scr, (const bf16*)(scr + SN_YF), (bf16*)(scr + SN_YF + (size_t)MTOK * DM * 2)); else nsa_selwin<0>(lds, tid, lane, wave, G, blk, scr, (const bf16*)(scr + SN_YF), Y); } END(pb + 5); } }
            }
            if (SEL(28) && PH(pb + 7)) { for (int rep_ = 0; rep_ < NREP(28); ++rep_) { LAUNDER pg8::EpiBf16<0> E{MF, DM, nullptr}; run_gemm(lds, Y, DM, (const bf16*)(ws + WS_WNSA_OUT) + (size_t)li * DM * DM, DM, MTOK, DM, DM, E, G, blk, tid); END(pb + 7); } }
        }
        if (SEL(9) && PH(pb + 8)) { for (int rep_ = 0; rep_ < NREP(9); ++rep_) { LAUNDER rowpass(gw, ngw, lane, MF, l == 0 ? a.in[0] : nullptr, HB, nullptr, HB, nw + (size_t)(l * 4 + 1) * DM, nw + (size_t)(l * 4 + 2) * DM, RS); END(pb + 8); } }
        if (SEL(10) && PH(pb + 9)) { for (int rep_ = 0; rep_ < NREP(10); ++rep_) { LAUNDER pg8::EpiAct E{(bf16*)(scr + SC_ACT), a.in[18] + (size_t)l * 3 * DFF, (float*)(ws + WS_SG), (float*)(ws + WS_S0), (LAS float*)(lds + 131072), DFF, RS}; run_gemm(lds, HB, DM, (const bf16*)(ws + WS_WGU) + (size_t)l * 2 * DFF * DM, DM, MTOK, 2 * DFF, DM, E, G, blk, tid); END(pb + 9); } }
        if (SEL(11) && PH(pb + 10)) { for (int rep_ = 0; rep_ < NREP(11); ++rep_) { LAUNDER ffn_fix(blk * NTHR + tid, G * NTHR, (const float*)(ws + WS_SG), (const float*)(ws + WS_S0), a.in[18] + (size_t)l * 3 * DFF, (bf16*)(scr + SC_ACT)); END(pb + 10); } }
        if (SEL(12) && PH(pb + 11)) { for (int rep_ = 0; rep_ < NREP(12); ++rep_) { LAUNDER pg8::EpiBf16<0> E{MF, DM, nullptr}; run_gemm(lds, (const bf16*)(scr + SC_ACT), DFF, (const bf16*)(ws + WS_WDN) + (size_t)l * DM * DFF, DFF, MTOK, DM, DFF, E, G, blk, tid); END(pb + 11); } }
        if (SEL(13) && PH(pb + 12)) { for (int rep_ = 0; rep_ < NREP(13); ++rep_) { LAUNDER rowpass(gw, ngw, lane, MF, nullptr, HB, l == 3 ? H : nullptr, HB, nw + (size_t)(l * 4 + 3) * DM, l < 3 ? nw + (size_t)((l + 1) * 4 + 0) * DM : nullptr, RS); END(pb + 12); } }
    }
#undef PH
#undef END
}

static bool phase_exists(int p) { if (p == 0) return true; const int l = (p - 1) / PH_PER_LAYER, k = (p - 1) % PH_PER_LAYER; if ((l & 1) == 0 && (k == 5 || k == 6 || k == 7)) return false; return true; }
extern "C" void kernel_launch(void* const* d_in, const int* in_sizes, int n_in, void* d_out, int out_size, void* d_ws, size_t ws_size, hipStream_t stream) {
    static int grid = 0;
    if (grid == 0) {
        if (n_in != 20 || out_size != MTOK * DM || ws_size < WS_END) { fprintf(stderr, "kernel_launch: unexpected shapes (n_in %d out %d ws %zu need %zu)\n", n_in, out_size, ws_size, (size_t)WS_END); grid = -1; return; }
        int dev = 0, cus = 0, per_cu = 0;
        if (hipGetDevice(&dev) != hipSuccess || hipDeviceGetAttribute(&cus, hipDeviceAttributeMultiprocessorCount, dev) != hipSuccess) { grid = -1; return; }
        if (hipFuncSetAttribute((const void*)fwd_kernel, hipFuncAttributeMaxDynamicSharedMemorySize, LDS_BYTES) != hipSuccess) { fprintf(stderr, "kernel_launch: hipFuncSetAttribute failed\n"); grid = -1; return; }
        if (hipOccupancyMaxActiveBlocksPerMultiprocessor(&per_cu, (const void*)fwd_kernel, NTHR, LDS_BYTES) != hipSuccess || per_cu < 1) { fprintf(stderr, "kernel_launch: occupancy query reports %d\n", per_cu); }
        (void)hipGetLastError();
        grid = cus;
    }
    if (grid < 0) return;
    (void)hipMemsetAsync((char*)d_ws + WS_CTL, 0, CTL_ZERO_BYTES, stream);
    Args a{};
    for (int i = 0; i < 20; ++i) a.in[i] = (const float*)d_in[i];
    a.out = (float*)d_out; a.ws = (unsigned char*)d_ws;
#if MK_MULTI
    for (int p = 0; p < NPHASE; ++p) { if (!phase_exists(p)) continue; a.ph_lo = p; a.ph_hi = p + 1; hipLaunchKernelGGL(fwd_kernel, dim3(grid), dim3(NTHR), LDS_BYTES, stream, a); }
#else
    a.ph_lo = 0; a.ph_hi = NPHASE; hipLaunchKernelGGL(fwd_kernel, dim3(grid), dim3(NTHR), LDS_BYTES, stream, a);
#endif
}
```
